# Optimizing an MI355X kernel written in HIP

```python
import math
import jax
import jax.numpy as jnp
from jax import lax
import numpy as np

D_MODEL = 1024
BATCH = 8
SEQ = 4096
DEPTH = 1

D_SSM = 512
SSM_CH = 16
SSM_GROUPS = D_SSM // SSM_CH
SSM_STATE = 64
N_HEADS = 8
N_KV = 2
HEAD_DIM = 64
GROUP = N_HEADS // N_KV
ATT_W = N_HEADS * HEAD_DIM
WINDOW = 128
BLOCK = 128
NUM_BUCKETS = 32
MAX_DIST = 128
D_IN = D_SSM + ATT_W + 2 * N_KV * HEAD_DIM
N_GROUPS = 4
EXPERTS_PER_GROUP = 8
N_EXPERTS = N_GROUPS * EXPERTS_PER_GROUP
TOP_K = 2
D_FF_EXPERT = 512
MOE_BLK = 256
PLE_DIM = 256
EPS = 1e-6

kernel_name = 'hybrid_s5_swa_sink_hiermoe_block'


def rmsnorm(x, g):
    xf = x.astype(jnp.float32)
    y = xf * lax.rsqrt(jnp.mean(xf * xf, axis=-1, keepdims=True) + EPS)
    return (y * g.astype(jnp.float32)).astype(x.dtype)


def t5_bucket(rel):
    max_exact = NUM_BUCKETS // 2
    relf = jnp.maximum(rel, 1).astype(jnp.float32)
    large = max_exact + (jnp.log(relf / max_exact) / math.log(MAX_DIST / max_exact)
                         * (NUM_BUCKETS - max_exact)).astype(jnp.int32)
    large = jnp.minimum(large, NUM_BUCKETS - 1)
    return jnp.where(rel < max_exact, rel, large)


def s5_mixer(u, a_re, a_im, log_dt, b_re, b_im, c_re, c_im, d_skip, w_glu, b_glu):
    bsz, seq, _ = u.shape
    f32 = jnp.float32
    uf = u.astype(f32).reshape(bsz, seq, SSM_GROUPS, SSM_CH)
    lam = lax.complex(a_re.astype(f32), a_im.astype(f32))
    dt = jnp.exp(log_dt.astype(f32))[:, None]
    a_bar = jnp.exp(lam * dt)
    b_mat = lax.complex(b_re.astype(f32), b_im.astype(f32))
    b_bar = ((a_bar - 1.0) / lam)[..., None] * b_mat
    bu = jnp.einsum('gpc,bsgc->bsgp', b_bar, uf.astype(jnp.complex64))
    a_elems = jnp.broadcast_to(a_bar, (1, seq, SSM_GROUPS, SSM_STATE))

    def combine(e1, e2):
        a1, s1 = e1
        a2, s2 = e2
        return a2 * a1, a2 * s1 + s2

    _, states = lax.associative_scan(combine, (a_elems, bu), axis=1)
    c_mat = lax.complex(c_re.astype(f32), c_im.astype(f32))
    y = jnp.real(jnp.einsum('gcp,bsgp->bsgc', c_mat, states))
    y = y + d_skip.astype(f32).reshape(SSM_GROUPS, SSM_CH) * uf
    y = jax.nn.gelu(y.reshape(bsz, seq, D_SSM))
    y = y * jax.nn.sigmoid(y @ w_glu.astype(f32) + b_glu.astype(f32))
    return y.astype(u.dtype)


def window_attention(q, k, v, rel_bias, sinks):
    bsz, seq = q.shape[0], q.shape[1]
    nb = seq // BLOCK
    qb = q.reshape(bsz, nb, BLOCK, N_KV, GROUP, HEAD_DIM)
    kb = k.reshape(bsz, nb, BLOCK, N_KV, HEAD_DIM)
    vb = v.reshape(bsz, nb, BLOCK, N_KV, HEAD_DIM)
    pad = ((0, 0), (1, 0), (0, 0), (0, 0), (0, 0))
    kwin = jnp.concatenate([jnp.pad(kb, pad)[:, :-1], kb], axis=2)
    vwin = jnp.concatenate([jnp.pad(vb, pad)[:, :-1], vb], axis=2)
    s = jnp.einsum('bnqkgd,bnckd->bnkgqc', qb, kwin).astype(jnp.float32) * (HEAD_DIM ** -0.5)
    q_loc = jnp.arange(BLOCK)[:, None]
    c_loc = jnp.arange(2 * BLOCK)[None, :]
    rel = q_loc + BLOCK - c_loc
    bias = rel_bias.astype(jnp.float32)[t5_bucket(jnp.maximum(rel, 0))]
    bias = bias.transpose(2, 0, 1).reshape(N_KV, GROUP, BLOCK, 2 * BLOCK)
    valid = (rel >= 0) & (rel < WINDOW)
    blk = jnp.arange(nb)[:, None, None]
    mask = valid[None] & ((blk > 0) | (c_loc[None] >= BLOCK))
    s = jnp.where(mask[None, :, None, None], s + bias, -jnp.inf)
    sink = sinks.astype(jnp.float32).reshape(N_KV, GROUP)[None, None, :, :, None, None]
    m = jnp.maximum(jnp.max(s, axis=-1, keepdims=True), sink)
    e = jnp.exp(s - m)
    pr = e / (jnp.sum(e, axis=-1, keepdims=True) + jnp.exp(sink - m))
    o = jnp.einsum('bnkgqc,bnckd->bnqkgd', pr.astype(v.dtype), vwin)
    return o.reshape(bsz, seq, ATT_W)


def hier_moe(h, w_rg, b_rg, w_re, b_re, w_eg, w_eu, w_ed):
    bsz, seq, dm = h.shape
    n_tok = bsz * seq
    ht = h.reshape(n_tok, dm)
    g_prob = jax.nn.softmax((ht @ w_rg + b_rg).astype(jnp.float32), axis=-1)
    g_top_p, g_idx = lax.top_k(g_prob, 1)
    e_logits = (ht @ w_re + b_re).astype(jnp.float32).reshape(n_tok, N_GROUPS, EXPERTS_PER_GROUP)
    idx = jnp.broadcast_to(g_idx[:, :, None], (n_tok, 1, EXPERTS_PER_GROUP))
    e_in = jnp.take_along_axis(e_logits, idx, axis=1)[:, 0]
    e_top_l, e_top_i = lax.top_k(e_in, TOP_K)
    e_w = jax.nn.softmax(e_top_l, axis=-1) * g_top_p
    expert = g_idx * EXPERTS_PER_GROUP + e_top_i
    n_slots = n_tok * TOP_K
    flat_e = expert.reshape(-1)
    flat_w = e_w.reshape(-1)
    flat_tok = jnp.arange(n_slots) // TOP_K
    order = jnp.argsort(flat_e)
    se = flat_e[order]
    tok_sorted = flat_tok[order]
    counts = jnp.bincount(flat_e, length=N_EXPERTS)
    padded = ((counts + MOE_BLK - 1) // MOE_BLK) * MOE_BLK
    pad_end = jnp.cumsum(padded)
    pad_start = pad_end - padded
    start = jnp.cumsum(counts) - counts
    dest = pad_start[se] + (jnp.arange(n_slots) - start[se])
    n_rows = n_slots + N_EXPERTS * MOE_BLK
    n_blk = n_rows // MOE_BLK
    xd = jnp.zeros((n_rows, dm), ht.dtype).at[dest].set(ht[tok_sorted])
    blk_e = jnp.minimum(jnp.searchsorted(pad_end, jnp.arange(n_blk) * MOE_BLK, side='right'),
                        N_EXPERTS - 1)

    def expert_block(args):
        xb, e = args
        return (jax.nn.silu(xb @ w_eg[e]) * (xb @ w_eu[e])) @ w_ed[e]

    yd = lax.map(expert_block, (xd.reshape(n_blk, MOE_BLK, dm), blk_e)).reshape(n_rows, dm)
    y_slots = yd[dest] * flat_w[order][:, None].astype(yd.dtype)
    out = jax.ops.segment_sum(y_slots, tok_sorted, num_segments=n_tok)
    return out.reshape(bsz, seq, dm).astype(h.dtype)


def setup_inputs(seed: int = 0) -> dict:
    key = jax.random.key(seed)
    ks = iter(jax.random.split(key, 48))
    L = DEPTH

    def nrm(shape, scale):
        return jax.random.normal(next(ks), shape, jnp.float32) * scale

    n_idx = jnp.arange(SSM_STATE, dtype=jnp.float32)
    return {
        'x': nrm((BATCH, SEQ, D_MODEL), 1.0),
        'p': nrm((DEPTH, BATCH, SEQ, PLE_DIM), 1.0),
        'rel_bias': nrm((NUM_BUCKETS, N_HEADS), 0.5),
        'g_mix': 1.0 + nrm((L, D_MODEL), 0.02),
        'w_in': nrm((L, D_MODEL, D_IN), D_MODEL ** -0.5),
        'w_gate': nrm((L, D_MODEL, 2 * D_MODEL), D_MODEL ** -0.5),
        'b_gate': nrm((L, 2 * D_MODEL), 0.02),
        'ssm_a_re': -0.5 + nrm((L, SSM_GROUPS, SSM_STATE), 0.01),
        'ssm_a_im': math.pi * n_idx + nrm((L, SSM_GROUPS, SSM_STATE), 0.01),
        'ssm_log_dt': jax.random.uniform(next(ks), (L, SSM_GROUPS), jnp.float32,
                                         minval=math.log(1e-3), maxval=math.log(1e-1)),
        'ssm_b_re': nrm((L, SSM_GROUPS, SSM_STATE, SSM_CH), (2 * SSM_CH) ** -0.5),
        'ssm_b_im': nrm((L, SSM_GROUPS, SSM_STATE, SSM_CH), (2 * SSM_CH) ** -0.5),
        'ssm_c_re': nrm((L, SSM_GROUPS, SSM_CH, SSM_STATE), (2 * SSM_STATE) ** -0.5),
        'ssm_c_im': nrm((L, SSM_GROUPS, SSM_CH, SSM_STATE), (2 * SSM_STATE) ** -0.5),
        'ssm_d': nrm((L, D_SSM), 1.0),
        'w_glu': nrm((L, D_SSM, D_SSM), D_SSM ** -0.5),
        'b_glu': nrm((L, D_SSM), 0.02),
        'sinks': nrm((L, N_HEADS), 0.5),
        'w_br_ssm': nrm((L, D_SSM, D_MODEL), D_SSM ** -0.5),
        'w_br_attn': nrm((L, ATT_W, D_MODEL), ATT_W ** -0.5),
        'w_out': nrm((L, D_MODEL, D_MODEL), D_MODEL ** -0.5),
        'g_ffn': 1.0 + nrm((L, D_MODEL), 0.02),
        'w_router_group': nrm((L, D_MODEL, N_GROUPS), D_MODEL ** -0.5),
        'b_router_group': nrm((L, N_GROUPS), 0.01),
        'w_router_expert': nrm((L, D_MODEL, N_EXPERTS), D_MODEL ** -0.5),
        'b_router_expert': nrm((L, N_EXPERTS), 0.01),
        'w_e_gate': nrm((L, N_EXPERTS, D_MODEL, D_FF_EXPERT), D_MODEL ** -0.5),
        'w_e_up': nrm((L, N_EXPERTS, D_MODEL, D_FF_EXPERT), D_MODEL ** -0.5),
        'w_e_down': nrm((L, N_EXPERTS, D_FF_EXPERT, D_MODEL), D_FF_EXPERT ** -0.5),
        'g_ple': 1.0 + nrm((L, D_MODEL), 0.02),
        'w_ple_gate': nrm((L, D_MODEL, D_MODEL), D_MODEL ** -0.5),
        'b_ple_gate': nrm((L, D_MODEL), 0.02),
        'w_ple_proj': nrm((L, PLE_DIM, D_MODEL), PLE_DIM ** -0.5),
        'g_final': 1.0 + nrm((D_MODEL,), 0.02),
    }


def reference(x, p, rel_bias, g_mix, w_in, w_gate, b_gate, ssm_a_re, ssm_a_im, ssm_log_dt,
              ssm_b_re, ssm_b_im, ssm_c_re, ssm_c_im, ssm_d, w_glu, b_glu, sinks,
              w_br_ssm, w_br_attn, w_out, g_ffn, w_router_group, b_router_group,
              w_router_expert, b_router_expert, w_e_gate, w_e_up, w_e_down,
              g_ple, w_ple_gate, b_ple_gate, w_ple_proj, g_final):
    bsz, seq, _ = x.shape
    for i in range(DEPTH):
        h = rmsnorm(x, g_mix[i])
        proj = h @ w_in[i]
        u = proj[..., :D_SSM]
        q = proj[..., D_SSM:D_SSM + ATT_W].reshape(bsz, seq, N_HEADS, HEAD_DIM)
        k = proj[..., D_SSM + ATT_W:D_SSM + ATT_W + N_KV * HEAD_DIM].reshape(bsz, seq, N_KV, HEAD_DIM)
        v = proj[..., D_SSM + ATT_W + N_KV * HEAD_DIM:].reshape(bsz, seq, N_KV, HEAD_DIM)
        y_ssm = s5_mixer(u, ssm_a_re[i], ssm_a_im[i], ssm_log_dt[i], ssm_b_re[i], ssm_b_im[i],
                         ssm_c_re[i], ssm_c_im[i], ssm_d[i], w_glu[i], b_glu[i])
        y_att = window_attention(q, k, v, rel_bias, sinks[i])
        gates = jax.nn.sigmoid(h @ w_gate[i] + b_gate[i]).reshape(bsz, seq, 2, D_MODEL)
        merged = gates[:, :, 0] * (y_ssm @ w_br_ssm[i]) + gates[:, :, 1] * (y_att @ w_br_attn[i])
        x = x + merged @ w_out[i]
        h2 = rmsnorm(x, g_ffn[i])
        x = x + hier_moe(h2, w_router_group[i], b_router_group[i], w_router_expert[i],
                         b_router_expert[i], w_e_gate[i], w_e_up[i], w_e_down[i])
        h3 = rmsnorm(x, g_ple[i])
        x = x + (p[i] @ w_ple_proj[i]) * jax.nn.sigmoid(h3 @ w_ple_gate[i] + b_ple_gate[i])
    return rmsnorm(x, g_final)
```

```cpp
#include <hip/hip_runtime.h>
#include <cstdio>
#include <cstdint>
namespace pg8 {
#define PG8_LAS __attribute__((address_space(3)))
typedef unsigned short bf16_t;
typedef short bf16x8 __attribute__((ext_vector_type(8)));
typedef float f32x4 __attribute__((ext_vector_type(4)));
typedef unsigned u32x4 __attribute__((ext_vector_type(4)));
constexpr int BM = 256, BK = 64, HALF = 128, HTB = HALF * BK * 2  , STAGE_BYTES = 8 * HTB, NXCD = 8, WGM = 8;

__host__ __device__ __forceinline__ int lds_byte(int r, int c) { const int st = (r >> 4) * 2 + (c >> 5), rr = r & 15, cc = c & 31, ob = rr * 64 + cc * 2; return st * 1024 + (ob ^ (((ob >> 9) & 1) << 5)); }
__host__ __device__ __forceinline__ void stage_rc(int b, int& R, int& C) { const int st = b / 1024, sb = b % 1024, swz = sb ^ (((sb >> 9) & 1) << 5); R = (st >> 1) * 16 + swz / 64; C = (st & 1) * 32 + (swz % 64) / 2; }
__host__ __device__ __forceinline__ int perm32(int rho) { const int n = rho >> 4, i = rho & 15; return 8 * (i >> 2) + 4 * n + (i & 3); }

struct Unit { int pm, pn; };
struct Gemm { const bf16_t* A; const bf16_t* Bt; int M, N, K; };

struct StaticOrder {
    int nM, nN, nwg, G, c;
    __host__ __device__ void init(int M, int N, int G_, int c_) { nM = M / BM; nN = N / BM; nwg = nM * nN; G = G_; c = c_; }
    __host__ __device__ bool next(int i, Unit& u) const {
        const long L = (long)i * G + c; if (L >= nwg) return false;
        int wgid = (int)L; { const int q = nwg / NXCD, r = nwg % NXCD, xcd = wgid % NXCD, off = wgid / NXCD; wgid = (xcd < r ? xcd * (q + 1) : r * (q + 1) + (xcd - r) * q) + off; }
        const int nig = WGM * nN, gid = wgid / nig, fm = gid * WGM, gsz = (nM - fm) < WGM ? (nM - fm) : WGM;
        u.pm = fm + ((wgid % nig) % gsz); u.pn = (wgid % nig) / gsz; return true;
    }
    __device__ __forceinline__ void a_ready(const Unit&) const {}
    __device__ __forceinline__ void done(const Unit&) const {}
};

__device__ __forceinline__ unsigned cvt_pk_bf16(float lo, float hi) { unsigned r; asm volatile("v_cvt_pk_bf16_f32 %0, %1, %2" : "=v"(r) : "v"(lo), "v"(hi)); return r; }
typedef float f32x2 __attribute__((ext_vector_type(2)));
template <class Epi, class Sched, bool ALIGN_EPI = false, bool SP2 = false>
__device__ __forceinline__ void gemm_phase(PG8_LAS unsigned char* lds, const Gemm g, const Sched& S, const Epi& E) {
    int tid_o = threadIdx.x; asm volatile("" : "+v"(tid_o));
    const int tid = tid_o, wid = __builtin_amdgcn_readfirstlane(tid >> 6), lane = tid & 63, wr = wid >> 2, wc = wid & 3, fr = lane & 15, fq = lane >> 4;
    const int K = g.K, nt = K / BK;
    unsigned voffA[2], voffB[2];
#pragma unroll
    for (int i = 0; i < 2; ++i) { int R, C; stage_rc(tid * 16 + i * 8192, R, C); const int Rb = Epi::PERM ? ((R & ~31) + perm32(R & 31)) : R;
        voffA[i] = (unsigned)(R * K + C) * 2u; voffB[i] = (unsigned)(Rb * K + C) * 2u; }
    const size_t kstep = (size_t)(BK * 2);
    const size_t hstep = (size_t)HALF * K * 2;
    const size_t tstep = 2 * hstep;
    const unsigned ldsw = (unsigned)wid * 1024u;
    const int aoff = lds_byte(wr * 64 + fr, fq * 8), boff = lds_byte(wc * 32 + fr, fq * 8);
#define PG8_SA(b, h) (((b) * 2 + (h)) * HTB)
#define PG8_SB(b, h) ((4 + (b) * 2 + (h)) * HTB)
#define PG8_STAGE(bufoff, gbase, voff) do { _Pragma("unroll") for (int _i = 0; _i < 2; ++_i) \
        __builtin_amdgcn_global_load_lds((const unsigned*)((const char*)(gbase) + (voff)[_i]), (PG8_LAS unsigned*)(lds + (bufoff) + ldsw + _i * 8192), 16, 0, 0); } while (0)
#define PG8_LDA(dst, b, h) do { _Pragma("unroll") for (int m = 0; m < 4; ++m) _Pragma("unroll") for (int k = 0; k < 2; ++k) dst[m][k] = *(const PG8_LAS bf16x8*)(lds + PG8_SA(b, h) + aoff + m * 2048 + k * 1024); } while (0)
#define PG8_LDB(dst, b, h) do { _Pragma("unroll") for (int n = 0; n < 2; ++n) _Pragma("unroll") for (int k = 0; k < 2; ++k) dst[n][k] = *(const PG8_LAS bf16x8*)(lds + PG8_SB(b, h) + boff + n * 2048 + k * 1024); } while (0)
#define PG8_MMA(ai, bj, At, Bt) do { __builtin_amdgcn_s_setprio(1); _Pragma("unroll") for (int m = 0; m < 4; ++m) _Pragma("unroll") for (int n = 0; n < 2; ++n) _Pragma("unroll") for (int k = 0; k < 2; ++k) \
        acc[ai][bj][m][n] = __builtin_amdgcn_mfma_f32_16x16x32_bf16(Bt[n][k], At[m][k], acc[ai][bj][m][n], 0, 0, 0); __builtin_amdgcn_s_setprio(0); } while (0)
#define PG8_WAIT_V(n) asm volatile("s_waitcnt vmcnt(" #n ")" ::: "memory")
#define PG8_WAIT_L(n) asm volatile("s_waitcnt lgkmcnt(" #n ")" ::: "memory")
#define PG8_BAR __builtin_amdgcn_s_barrier()
#define PG8_SCHED __builtin_amdgcn_sched_barrier(0)
    Unit cur, nxt; int ui = 0;
    if (!S.next(0, cur)) return;
    f32x4 acc[2][2][4][2];
#pragma unroll
    for (int a = 0; a < 2; ++a)
#pragma unroll
        for (int b = 0; b < 2; ++b)
#pragma unroll
            for (int m = 0; m < 4; ++m)
#pragma unroll
                for (int n = 0; n < 2; ++n) acc[a][b][m][n] = (f32x4){0.f, 0.f, 0.f, 0.f};
    bf16x8 At[4][2], B0[2][2], B1[2][2];
    const char* cA = (const char*)g.A + (size_t)cur.pm * tstep; const char* cB = (const char*)g.Bt + (size_t)cur.pn * tstep;
    S.a_ready(cur);
    if constexpr (SP2) {
        PG8_STAGE(PG8_SB(0, 0), cB, voffB); PG8_STAGE(PG8_SB(0, 1), cB + hstep, voffB); PG8_STAGE(PG8_SA(0, 0), cA, voffA); PG8_STAGE(PG8_SA(0, 1), cA + hstep, voffA);
        if (wr == 1) PG8_BAR;
        PG8_WAIT_V(2); PG8_BAR;
        PG8_STAGE(PG8_SB(1, 0), cB + kstep, voffB); PG8_STAGE(PG8_SA(1, 0), cA + kstep, voffA); PG8_STAGE(PG8_SB(1, 1), cB + hstep + kstep, voffB);
        PG8_WAIT_V(6); PG8_BAR;
    } else {
        PG8_STAGE(PG8_SB(0, 0), cB, voffB); PG8_STAGE(PG8_SA(0, 0), cA, voffA); PG8_STAGE(PG8_SB(0, 1), cB + hstep, voffB); PG8_STAGE(PG8_SA(0, 1), cA + hstep, voffA);
        if (wr == 1) PG8_BAR;
        PG8_WAIT_V(4); PG8_BAR;
        PG8_STAGE(PG8_SB(1, 0), cB + kstep, voffB); PG8_STAGE(PG8_SA(1, 0), cA + kstep, voffA); PG8_STAGE(PG8_SB(1, 1), cB + hstep + kstep, voffB);
        PG8_WAIT_V(6); PG8_BAR;
    }
    for (;;) {
        const bool has_next = S.next(ui + 1, nxt);
        const char* nA = has_next ? (const char*)g.A + (size_t)nxt.pm * tstep : cA; const char* nB = has_next ? (const char*)g.Bt + (size_t)nxt.pn * tstep : cB;
#pragma nounroll
        for (int t = 0; t < nt; t += 2) {
            const bool last = (t == nt - 2);
            const char* a1 = cA + (size_t)(t + 1) * kstep;
            const char* a2 = last ? nA : cA + (size_t)(t + 2) * kstep; const char* b2 = last ? nB : cB + (size_t)(t + 2) * kstep;
            const char* a3 = a2 + kstep; const char* b3 = b2 + kstep;
            if (last && has_next) S.a_ready(nxt);
            if constexpr (SP2) {
            PG8_LDB(B0, 0, 0); PG8_LDB(B1, 0, 1); PG8_SCHED; PG8_LDA(At, 0, 0); PG8_STAGE(PG8_SA(1, 1), a1 + hstep, voffA);
            PG8_WAIT_V(8); PG8_WAIT_L(0); PG8_BAR; PG8_MMA(0, 0, At, B0); PG8_MMA(0, 1, At, B1); PG8_BAR; PG8_SCHED;
            PG8_LDA(At, 0, 1); PG8_STAGE(PG8_SB(0, 0), b2, voffB); PG8_STAGE(PG8_SB(0, 1), b2 + hstep, voffB); PG8_STAGE(PG8_SA(0, 0), a2, voffA);
            PG8_WAIT_V(8); PG8_WAIT_L(0); PG8_BAR; PG8_MMA(1, 0, At, B0); PG8_MMA(1, 1, At, B1); PG8_BAR; PG8_SCHED;
            PG8_LDB(B0, 1, 0); PG8_LDB(B1, 1, 1); PG8_SCHED; PG8_LDA(At, 1, 0); PG8_STAGE(PG8_SA(0, 1), a2 + hstep, voffA);
            PG8_WAIT_V(8); PG8_WAIT_L(0); PG8_BAR; PG8_MMA(0, 0, At, B0); PG8_MMA(0, 1, At, B1); PG8_BAR; PG8_SCHED;
            PG8_LDA(At, 1, 1); PG8_STAGE(PG8_SB(1, 0), b3, voffB); PG8_STAGE(PG8_SB(1, 1), b3 + hstep, voffB); PG8_STAGE(PG8_SA(1, 0), a3, voffA);
            PG8_WAIT_V(8); PG8_WAIT_L(0); PG8_BAR; PG8_MMA(1, 0, At, B0); PG8_MMA(1, 1, At, B1); PG8_BAR; PG8_SCHED;
            } else {
            PG8_LDB(B0, 0, 0); PG8_SCHED; PG8_LDA(At, 0, 0); PG8_STAGE(PG8_SA(1, 1), a1 + hstep, voffA);
            PG8_WAIT_L(8); PG8_BAR; PG8_WAIT_L(0); PG8_MMA(0, 0, At, B0); PG8_BAR; PG8_SCHED;
            PG8_LDB(B1, 0, 1); PG8_STAGE(PG8_SB(0, 0), b2, voffB);
            PG8_BAR; PG8_WAIT_L(0); PG8_MMA(0, 1, At, B1); PG8_BAR;
            PG8_LDA(At, 0, 1); PG8_STAGE(PG8_SA(0, 0), a2, voffA);
            PG8_BAR; PG8_WAIT_L(0); PG8_MMA(1, 0, At, B0); PG8_BAR; PG8_SCHED;
            PG8_STAGE(PG8_SB(0, 1), b2 + hstep, voffB);
            PG8_WAIT_V(6); PG8_BAR; PG8_MMA(1, 1, At, B1); PG8_BAR;
            PG8_LDB(B0, 1, 0); PG8_SCHED; PG8_LDA(At, 1, 0); PG8_STAGE(PG8_SA(0, 1), a2 + hstep, voffA);
            PG8_WAIT_L(8); PG8_BAR; PG8_WAIT_L(0); PG8_MMA(0, 0, At, B0); PG8_BAR; PG8_SCHED;
            PG8_LDB(B1, 1, 1); PG8_STAGE(PG8_SB(1, 0), b3, voffB);
            PG8_BAR; PG8_WAIT_L(0); PG8_MMA(0, 1, At, B1); PG8_BAR;
            PG8_LDA(At, 1, 1); PG8_STAGE(PG8_SA(1, 0), a3, voffA);
            PG8_BAR; PG8_WAIT_L(0); PG8_MMA(1, 0, At, B0); PG8_BAR; PG8_SCHED;
            PG8_STAGE(PG8_SB(1, 1), b3 + hstep, voffB);
            PG8_WAIT_V(6); PG8_BAR; PG8_MMA(1, 1, At, B1); PG8_BAR;
            }
        }
        if constexpr (ALIGN_EPI) { if (wr == 0) PG8_BAR; }
        if constexpr (!Epi::AFTER_DRAIN) { int lane_e = lane; asm volatile("" : "+v"(lane_e)); E(acc, cur, wr, wc, lane_e & 15, lane_e >> 4); S.done(cur); }
        if (!has_next) break;
#pragma unroll
        for (int a = 0; a < 2; ++a)
#pragma unroll
            for (int b = 0; b < 2; ++b)
#pragma unroll
                for (int m = 0; m < 4; ++m)
#pragma unroll
                    for (int n = 0; n < 2; ++n) acc[a][b][m][n] = (f32x4){0.f, 0.f, 0.f, 0.f};
        cur = nxt; cA = nA; cB = nB; ++ui;
        if constexpr (ALIGN_EPI) { if (wr == 1) PG8_BAR; }
    }
    PG8_WAIT_V(0);
    if constexpr (!ALIGN_EPI) { if (wr == 0) PG8_BAR; }
    PG8_BAR;
    if constexpr (Epi::AFTER_DRAIN) { int lane_e = lane; asm volatile("" : "+v"(lane_e)); E.fused(acc, cur, wr, wc, lane_e & 15, lane_e >> 4, lds, wid, lane_e); S.done(cur); }
#undef PG8_SA
#undef PG8_SB
#undef PG8_STAGE
#undef PG8_LDA
#undef PG8_LDB
#undef PG8_MMA
#undef PG8_WAIT_V
#undef PG8_WAIT_L
#undef PG8_BAR
#undef PG8_SCHED
}
}

typedef unsigned short bf16;
typedef pg8::f32x4 f32x4;
typedef pg8::u32x4 u32x4;
typedef pg8::bf16x8 bf16x8;
typedef unsigned u32x2 __attribute__((ext_vector_type(2)));
typedef float f32x16 __attribute__((ext_vector_type(16)));
typedef short v4i16_t __attribute__((ext_vector_type(4)));
#define LAS __attribute__((address_space(3)))

constexpr int TOK = 32768, DM = 1024, SEQ = 4096;
constexpr int NSLOT = 2 * TOK, MAXROWS = NSLOT + 32 * 256, MAXBLK = MAXROWS / 256;
constexpr float LOG2E = 1.4426950408889634f;
constexpr float QSCALE = 0.125f * LOG2E;
constexpr float RMS_EPS = 1e-6f;
constexpr int NWAVES = 8;

constexpr size_t MiB = 1u << 20;
constexpr size_t WS_CTL = 0, CTL_ZERO_BYTES = 1 * MiB;
constexpr size_t WS_A16 = 1 * MiB;
constexpr size_t WS_RSS1 = 2 * MiB;
constexpr size_t WS_RSTD1 = 4 * MiB;
constexpr size_t WS_RSTD2 = 4 * MiB + 256 * 1024;
constexpr size_t WS_SLOT_E = 5 * MiB;
constexpr size_t WS_SLOT_POS = 5 * MiB + 256 * 1024;
constexpr size_t WS_SLOT_W = 5 * MiB + 512 * 1024;
constexpr size_t WS_SLOT_DEST = 5 * MiB + 768 * 1024;
constexpr size_t WS_DEST_W = 6 * MiB;
constexpr size_t WS_DEST_RSTD = 6 * MiB + 512 * 1024;
constexpr size_t WS_WCAT = 9 * MiB;
constexpr size_t WS_WGLU = WS_WCAT + 6656 * 1024;
constexpr size_t WS_WR = 16 * MiB;
constexpr size_t WS_WPLE = 16 * MiB + 512 * 1024;
constexpr size_t WS_WA = 17 * MiB, WS_WB = 18 * MiB, WS_WOUT = 19 * MiB, WS_WPG = 21 * MiB;
constexpr size_t WS_M1T = 23 * MiB;
constexpr size_t WS_BSSM = 25 * MiB;
constexpr size_t WS_WGU = 32 * MiB;
constexpr size_t WS_WD = 96 * MiB;
constexpr size_t WS_R1 = 128 * MiB;
constexpr size_t WS_ASSM = 192 * MiB;
constexpr size_t WS_QKV = 240 * MiB;
constexpr size_t WS_MERGED = 192 * MiB;
constexpr size_t WS_GATES = 288 * MiB;
constexpr size_t WS_YATT = 416 * MiB;
constexpr size_t WS_YG = 448 * MiB;
constexpr size_t WS_PB = 480 * MiB;
constexpr size_t WS_XD = 192 * MiB;
constexpr size_t WS_ACT = 336 * MiB;
constexpr size_t WS_PP = 408 * MiB;
constexpr size_t WS_END = 496 * MiB;
constexpr int CW_BAR = 4096;
constexpr int CW_CNT = 8192;
constexpr int CW_BLK = 12288;

constexpr int RING_OFF = 0, RING_BYTES = 131072;
constexpr int LDSCTL_OFF = RING_BYTES, MISC_OFF = LDSCTL_OFF + 320;
constexpr int EXTRA_OFF = RING_BYTES + 1024;
constexpr int LDS_BYTES = 147456;

#define RLX_AGENT __ATOMIC_RELAXED, __HIP_MEMORY_SCOPE_AGENT
#define LDS_WAIT() asm volatile("s_waitcnt lgkmcnt(0)" ::: "memory")
#define VM_WAIT() asm volatile("s_waitcnt vmcnt(0)" ::: "memory")
typedef unsigned gu32;

typedef float f32x2_t __attribute__((ext_vector_type(2))); typedef __bf16 bf16x2_t __attribute__((ext_vector_type(2)));
__device__ __forceinline__ unsigned pk2(float lo, float hi) { f32x2_t v = {lo, hi}; bf16x2_t b = __builtin_convertvector(v, bf16x2_t); return __builtin_bit_cast(unsigned, b); }
__device__ __forceinline__ float bflo(unsigned w) { return __uint_as_float(w << 16); }
__device__ __forceinline__ float bfhi(unsigned w) { return __uint_as_float(w & 0xffff0000u); }
__device__ __forceinline__ float ex2(float x) { return __builtin_amdgcn_exp2f(x); }
__device__ __forceinline__ float sigm(float x) { return __builtin_amdgcn_rcpf(1.0f + ex2(-x * LOG2E)); }
__device__ __forceinline__ float gelu_tanh(float x) { const float z = 1.5957691216057308f * (x + 0.044715f * x * x * x); return x * sigm(z); }
__device__ __forceinline__ float wave_sum(float v) {
#pragma unroll
    for (int o = 1; o < 64; o <<= 1) v += __shfl_xor(v, o);
    return v;
}
__device__ __forceinline__ u32x4 pack8(const f32x4& a, const f32x4& b) { u32x4 w; w.x = pk2(a[0], a[1]); w.y = pk2(a[2], a[3]); w.z = pk2(b[0], b[1]); w.w = pk2(b[2], b[3]); return w; }
__device__ __forceinline__ void unpack8(const u32x4& w, f32x4& a, f32x4& b) { a[0] = bflo(w.x); a[1] = bfhi(w.x); a[2] = bflo(w.y); a[3] = bfhi(w.y); b[0] = bflo(w.z); b[1] = bfhi(w.z); b[2] = bflo(w.w); b[3] = bfhi(w.w); }

struct OneUnit {
    int pm, pn; bool have;
    __device__ __forceinline__ bool next(int i, pg8::Unit& u) const { if (i > 0 || !have) return false; u.pm = pm; u.pn = pn; return true; }
    __device__ __forceinline__ void a_ready(const pg8::Unit&) const {}
    __device__ __forceinline__ void done(const pg8::Unit&) const {}
};
struct MoeOrder {
    int total, G, c; const LAS int* blk;
    __device__ __forceinline__ bool next(int i, pg8::Unit& u) const {
        const int L = i * G + c; if (L >= total) return false;
        const int rb = L >> 2; u.pm = rb; u.pn = __builtin_amdgcn_readfirstlane(blk[1 + rb]) * 4 + (L & 3); return true; }
    __device__ __forceinline__ void a_ready(const pg8::Unit&) const {}
    __device__ __forceinline__ void done(const pg8::Unit&) const {}
};

typedef const f32x4 (&AccRef)[2][2][4][2];

struct Epi1 {
    static constexpr bool PERM = true, AFTER_DRAIN = false;
    bf16* Assm; bf16* qkv; bf16* gates; const float* bgate;
    __device__ __forceinline__ void operator()(AccRef acc, const pg8::Unit& u, int wr, int wc, int fr, int fq) const {
        const int pn = u.pn, row0 = u.pm * 256 + wr * 64 + fr, cl0 = wc * 32 + 8 * fq;
        if (pn < 2) {
#pragma unroll
            for (int ai = 0; ai < 2; ++ai)
#pragma unroll
                for (int m = 0; m < 4; ++m) { const int r = row0 + ai * 128 + m * 16, chunk = r >> 4, s = r & 15;
#pragma unroll
                    for (int bj = 0; bj < 2; ++bj) { const int col = pn * 256 + bj * 128 + cl0, g = col >> 4, c = col & 15;
                        *(u32x4*)(Assm + ((size_t)(g * 2048 + chunk) * 384 + s * 16 + c)) = pack8(acc[ai][bj][m][0], acc[ai][bj][m][1]); } }
        } else if (pn < 5) {
            const float sc = (pn < 4) ? QSCALE : 1.0f;
#pragma unroll
            for (int ai = 0; ai < 2; ++ai)
#pragma unroll
                for (int m = 0; m < 4; ++m) { const int r = row0 + ai * 128 + m * 16;
#pragma unroll
                    for (int bj = 0; bj < 2; ++bj) { const int col = pn * 256 + bj * 128 + cl0 - 512;
                        *(u32x4*)(qkv + (size_t)r * 768 + col) = pack8(acc[ai][bj][m][0] * sc, acc[ai][bj][m][1] * sc); } }
        } else {
#pragma unroll
            for (int bj = 0; bj < 2; ++bj) { const int gcol = (pn - 5) * 256 + bj * 128 + cl0;
                const f32x4 b0 = *(const f32x4*)(bgate + gcol), b1 = *(const f32x4*)(bgate + gcol + 4);
#pragma unroll
                for (int ai = 0; ai < 2; ++ai)
#pragma unroll
                    for (int m = 0; m < 4; ++m) { const int r = row0 + ai * 128 + m * 16; f32x4 v0 = acc[ai][bj][m][0] + b0, v1 = acc[ai][bj][m][1] + b1;
#pragma unroll
                        for (int i = 0; i < 4; ++i) { v0[i] = sigm(v0[i]); v1[i] = sigm(v1[i]); }
                        *(u32x4*)(gates + (size_t)r * 2048 + gcol) = pack8(v0, v1); } }
        }
    }
};
struct EpiSsm {
    static constexpr bool PERM = true, AFTER_DRAIN = false;
    bf16* yg;
    __device__ __forceinline__ void operator()(AccRef acc, const pg8::Unit& u, int wr, int wc, int fr, int fq) const {
        const int g = u.pn, row0 = u.pm * 256 + wr * 64 + fr, cl0 = wc * 32 + 8 * fq;
#pragma unroll
        for (int bj = 0; bj < 2; ++bj) { const int n = bj * 128 + cl0, s = n >> 4, c = n & 15;
#pragma unroll
            for (int ai = 0; ai < 2; ++ai)
#pragma unroll
                for (int m = 0; m < 4; ++m) { const int R = row0 + ai * 128 + m * 16, chunk = R & 2047;
                    f32x4 v0 = acc[ai][bj][m][0], v1 = acc[ai][bj][m][1];
#pragma unroll
                    for (int i = 0; i < 4; ++i) { v0[i] = gelu_tanh(v0[i]); v1[i] = gelu_tanh(v1[i]); }
                    *(u32x4*)(yg + (size_t)(chunk * 16 + s) * 512 + g * 16 + c) = pack8(v0, v1); } }
    }
};
struct EpiGlu {
    static constexpr bool PERM = true, AFTER_DRAIN = false;
    const bf16* yg; bf16* yssm; const float* bglu;
    __device__ __forceinline__ void operator()(AccRef acc, const pg8::Unit& u, int wr, int wc, int fr, int fq) const {
        const int row0 = u.pm * 256 + wr * 64 + fr, cl0 = u.pn * 256 + wc * 32 + 8 * fq;
#pragma unroll
        for (int bj = 0; bj < 2; ++bj) { const int col = bj * 128 + cl0;
            const f32x4 b0 = *(const f32x4*)(bglu + col), b1 = *(const f32x4*)(bglu + col + 4);
#pragma unroll
            for (int ai = 0; ai < 2; ++ai)
#pragma unroll
                for (int m = 0; m < 4; ++m) { const int r = row0 + ai * 128 + m * 16;
                    const u32x4 yw = *(const u32x4*)(yg + (size_t)r * 512 + col); f32x4 y0, y1; unpack8(yw, y0, y1);
                    f32x4 v0 = acc[ai][bj][m][0] + b0, v1 = acc[ai][bj][m][1] + b1;
#pragma unroll
                    for (int i = 0; i < 4; ++i) { v0[i] = y0[i] * sigm(v0[i]); v1[i] = y1[i] * sigm(v1[i]); }
                    *(u32x4*)(yssm + (size_t)r * 512 + col) = pack8(v0, v1); } }
    }
};
template <bool ADD> struct EpiBranch {
    static constexpr bool PERM = true, AFTER_DRAIN = false;
    const bf16* gates; int goff; const bf16* addend; bf16* out;
    __device__ __forceinline__ void operator()(AccRef acc, const pg8::Unit& u, int wr, int wc, int fr, int fq) const {
        const int row0 = u.pm * 256 + wr * 64 + fr, cl0 = u.pn * 256 + wc * 32 + 8 * fq;
#pragma unroll
        for (int ai = 0; ai < 2; ++ai)
#pragma unroll
            for (int m = 0; m < 4; ++m) { const int r = row0 + ai * 128 + m * 16;
#pragma unroll
                for (int bj = 0; bj < 2; ++bj) { const int col = bj * 128 + cl0;
                    const u32x4 gw = *(const u32x4*)(gates + (size_t)r * 2048 + goff + col); f32x4 g0, g1; unpack8(gw, g0, g1);
                    f32x4 v0 = g0 * acc[ai][bj][m][0], v1 = g1 * acc[ai][bj][m][1];
                    if (ADD) { const u32x4 aw = *(const u32x4*)(addend + (size_t)r * 1024 + col); f32x4 a0, a1; unpack8(aw, a0, a1); v0 += a0; v1 += a1; }
                    *(u32x4*)(out + (size_t)r * 1024 + col) = pack8(v0, v1); } }
    }
};
struct EpiPlain {
    static constexpr bool PERM = true, AFTER_DRAIN = false;
    bf16* out; int ldc;
    __device__ __forceinline__ void operator()(AccRef acc, const pg8::Unit& u, int wr, int wc, int fr, int fq) const {
        const int row0 = u.pm * 256 + wr * 64 + fr, cl0 = u.pn * 256 + wc * 32 + 8 * fq;
#pragma unroll
        for (int ai = 0; ai < 2; ++ai)
#pragma unroll
            for (int m = 0; m < 4; ++m) { const int r = row0 + ai * 128 + m * 16;
#pragma unroll
                for (int bj = 0; bj < 2; ++bj) *(u32x4*)(out + (size_t)r * ldc + bj * 128 + cl0) = pack8(acc[ai][bj][m][0], acc[ai][bj][m][1]); }
    }
};
struct EpiWout {
    static constexpr bool PERM = false, AFTER_DRAIN = false;
    const float* x; float* xout; bf16* xg; const float* gain; float* rss;
    __device__ __forceinline__ void operator()(AccRef acc, const pg8::Unit& u, int wr, int wc, int fr, int fq) const {
        const int row0 = u.pm * 256 + wr * 64 + fr, col0 = u.pn * 256 + wc * 32 + 4 * fq;
        f32x4 gv[2][2];
#pragma unroll
        for (int bj = 0; bj < 2; ++bj)
#pragma unroll
            for (int n = 0; n < 2; ++n) gv[bj][n] = *(const f32x4*)(gain + col0 + bj * 128 + n * 16);
#pragma unroll
        for (int ai = 0; ai < 2; ++ai)
#pragma unroll
            for (int m = 0; m < 4; ++m) { const int r = row0 + ai * 128 + m * 16; const size_t off = (size_t)r * 1024 + col0; float ss = 0.f;
#pragma unroll
                for (int bj = 0; bj < 2; ++bj)
#pragma unroll
                    for (int n = 0; n < 2; ++n) { const f32x4 xv = *(const f32x4*)(x + off + bj * 128 + n * 16); const f32x4 v = xv + acc[ai][bj][m][n];
                        *(f32x4*)(xout + off + bj * 128 + n * 16) = v; ss += (v[0] * v[0] + v[1] * v[1]) + (v[2] * v[2] + v[3] * v[3]);
                        const f32x4 w = v * gv[bj][n]; u32x2 o; o.x = pk2(w[0], w[1]); o.y = pk2(w[2], w[3]); *(u32x2*)(xg + off + bj * 128 + n * 16) = o; }
                ss += __shfl_xor(ss, 16); ss += __shfl_xor(ss, 32);
                if (fq == 0) rss[(size_t)r * 16 + u.pn * 4 + wc] = ss; }
    }
};
struct EpiPle {
    static constexpr bool PERM = false, AFTER_DRAIN = false;
    float* xio; const bf16* pp; const float* rstd; const float* bias;
    __device__ __forceinline__ void operator()(AccRef acc, const pg8::Unit& u, int wr, int wc, int fr, int fq) const {
        const int row0 = u.pm * 256 + wr * 64 + fr, col0 = u.pn * 256 + wc * 32 + 4 * fq;
        f32x4 bv[2][2];
#pragma unroll
        for (int bj = 0; bj < 2; ++bj)
#pragma unroll
            for (int n = 0; n < 2; ++n) bv[bj][n] = *(const f32x4*)(bias + col0 + bj * 128 + n * 16);
#pragma unroll
        for (int ai = 0; ai < 2; ++ai)
#pragma unroll
            for (int m = 0; m < 4; ++m) { const int r = row0 + ai * 128 + m * 16; const size_t off = (size_t)r * 1024 + col0; const float rs = rstd[r];
#pragma unroll
                for (int bj = 0; bj < 2; ++bj)
#pragma unroll
                    for (int n = 0; n < 2; ++n) { const size_t o = off + bj * 128 + n * 16; const f32x4 xv = *(const f32x4*)(xio + o);
                        const u32x2 pw = *(const u32x2*)(pp + o); f32x4 v = acc[ai][bj][m][n] * rs + bv[bj][n];
                        v[0] = xv[0] + bflo(pw.x) * sigm(v[0]); v[1] = xv[1] + bfhi(pw.x) * sigm(v[1]); v[2] = xv[2] + bflo(pw.y) * sigm(v[2]); v[3] = xv[3] + bfhi(pw.y) * sigm(v[3]);
                        *(f32x4*)(xio + o) = v; } }
    }
};
struct EpiMoe1 {
    static constexpr bool PERM = true, AFTER_DRAIN = false;
    bf16* act; const float* drstd;
    __device__ __forceinline__ void operator()(AccRef acc, const pg8::Unit& u, int wr, int wc, int fr, int fq) const {
        const int row0 = u.pm * 256 + wr * 64 + fr, col0 = (u.pn & 3) * 128 + wc * 32 + 8 * fq;
#pragma unroll
        for (int ai = 0; ai < 2; ++ai)
#pragma unroll
            for (int m = 0; m < 4; ++m) { const int r = row0 + ai * 128 + m * 16; const float rs = drstd[r]; f32x4 o[2];
#pragma unroll
                for (int n = 0; n < 2; ++n)
#pragma unroll
                    for (int i = 0; i < 4; ++i) { const float gq = acc[ai][0][m][n][i] * rs, uq = acc[ai][1][m][n][i] * rs; o[n][i] = gq * sigm(gq) * uq; }
                *(u32x4*)(act + (size_t)r * 512 + col0) = pack8(o[0], o[1]); }
    }
};
struct EpiMoe2 {
    static constexpr bool PERM = true, AFTER_DRAIN = false;
    bf16* yd; const float* dw;
    __device__ __forceinline__ void operator()(AccRef acc, const pg8::Unit& u, int wr, int wc, int fr, int fq) const {
        const int row0 = u.pm * 256 + wr * 64 + fr, cl0 = (u.pn & 3) * 256 + wc * 32 + 8 * fq;
#pragma unroll
        for (int ai = 0; ai < 2; ++ai)
#pragma unroll
            for (int m = 0; m < 4; ++m) { const int r = row0 + ai * 128 + m * 16; const float w = dw[r];
#pragma unroll
                for (int bj = 0; bj < 2; ++bj) *(u32x4*)(yd + (size_t)r * 1024 + bj * 128 + cl0) = pack8(acc[ai][bj][m][0] * w, acc[ai][bj][m][1] * w); }
    }
};
struct EpiRouter {
    static constexpr bool PERM = false, AFTER_DRAIN = true;
    const float* rss; float* rstd1; const float* brg; const float* bre; unsigned* cnt; int* slot_e; int* slot_pos; float* slot_w;
    __device__ __forceinline__ void fused(f32x4 (&acc)[2][2][4][2], const pg8::Unit& u, int wr, int wc, int fr, int fq, PG8_LAS unsigned char* lds, int wid, int lane) const {
        PG8_LAS float* lg = (PG8_LAS float*)lds;
        PG8_LAS int* lh = (PG8_LAS int*)(lds + 40960);
        int tid_q = wid * 64 + lane; asm volatile("" : "+v"(tid_q)); const int tid = tid_q;
        if (tid < 32) lh[tid] = 0;
#pragma unroll
        for (int ai = 0; ai < 2; ++ai)
#pragma unroll
            for (int m = 0; m < 4; ++m) { const int rl = ai * 128 + wr * 64 + m * 16 + fr;
                if (wc == 0) { *(PG8_LAS f32x4*)(lg + rl * 40 + 4 * fq) = acc[ai][0][m][0]; *(PG8_LAS f32x4*)(lg + rl * 40 + 16 + 4 * fq) = acc[ai][0][m][1]; }
                if (wc == 1 && fq == 0) *(PG8_LAS f32x4*)(lg + rl * 40 + 32) = acc[ai][0][m][0]; }
        asm volatile("s_waitcnt lgkmcnt(0)" ::: "memory"); __builtin_amdgcn_s_barrier(); asm volatile("" ::: "memory");
        int e0 = 0, e1 = 0, lp0 = 0, lp1 = 0; float w0 = 0.f, w1 = 0.f; const int R = u.pm * 256 + tid;
        if (tid < 256) {
            float ss = 0.f;
#pragma unroll
            for (int j = 0; j < 16; ++j) ss += rss[(size_t)R * 16 + j];
            const float rs = __builtin_amdgcn_rsqf(ss * (1.0f / 1024.0f) + RMS_EPS);
            rstd1[R] = rs;
            float gl[4];
#pragma unroll
            for (int j = 0; j < 4; ++j) gl[j] = lg[tid * 40 + j] * rs + brg[j];
            int gi = 0; float gm = gl[0];
#pragma unroll
            for (int j = 1; j < 4; ++j) if (gl[j] > gm) { gm = gl[j]; gi = j; }
            float gs = 0.f;
#pragma unroll
            for (int j = 0; j < 4; ++j) gs += ex2((gl[j] - gm) * LOG2E);
            const float gp = 1.0f / gs;
            float el[8];
#pragma unroll
            for (int j = 0; j < 8; ++j) el[j] = lg[tid * 40 + 4 + gi * 8 + j] * rs + bre[gi * 8 + j];
            int i0 = 0; float m0 = el[0];
#pragma unroll
            for (int j = 1; j < 8; ++j) if (el[j] > m0) { m0 = el[j]; i0 = j; }
            int i1 = -1; float m1 = -INFINITY;
#pragma unroll
            for (int j = 0; j < 8; ++j) if (j != i0 && el[j] > m1) { m1 = el[j]; i1 = j; }
            const float t = ex2((m1 - m0) * LOG2E);
            w0 = gp / (1.0f + t); w1 = gp * t / (1.0f + t);
            e0 = gi * 8 + i0; e1 = gi * 8 + i1;
            lp0 = __hip_atomic_fetch_add(lh + e0, 1, __ATOMIC_RELAXED, __HIP_MEMORY_SCOPE_WORKGROUP);
            lp1 = __hip_atomic_fetch_add(lh + e1, 1, __ATOMIC_RELAXED, __HIP_MEMORY_SCOPE_WORKGROUP);
        }
        asm volatile("s_waitcnt lgkmcnt(0)" ::: "memory"); __builtin_amdgcn_s_barrier(); asm volatile("" ::: "memory");
        if (tid < 32) { const int c = lh[tid]; lh[32 + tid] = (int)__hip_atomic_fetch_add(cnt + tid, (unsigned)c, __ATOMIC_RELAXED, __HIP_MEMORY_SCOPE_AGENT); }
        asm volatile("s_waitcnt vmcnt(0) lgkmcnt(0)" ::: "memory"); __builtin_amdgcn_s_barrier(); asm volatile("" ::: "memory");
        if (tid < 256) {
            slot_e[2 * R] = e0; slot_e[2 * R + 1] = e1; slot_pos[2 * R] = lh[32 + e0] + lp0; slot_pos[2 * R + 1] = lh[32 + e1] + lp1;
            slot_w[2 * R] = w0; slot_w[2 * R + 1] = w1;
        }
    }
};
#define XB_TMO      128
#define XB_XCNT(j)  (256  + 64 * (j))
#define XB_XSUB(j)  (1280 + 64 * (j))
#define XB_XGEN(j)  (2304 + 64 * (j))
#define XB_TOP      3328
#define XB_TOPGEN   3392
#define XCD_BAR_WORDS 3456
#define XB_SPIN_CAP (1u << 18)

__device__ __forceinline__ unsigned xb_ld(unsigned* p)              { return __hip_atomic_load(p, __ATOMIC_RELAXED, __HIP_MEMORY_SCOPE_AGENT); }
__device__ __forceinline__ unsigned xb_add(unsigned* p, unsigned v) { return __hip_atomic_fetch_add(p, v, __ATOMIC_RELAXED, __HIP_MEMORY_SCOPE_AGENT); }
__device__ __forceinline__ unsigned xb_xcc_id() { return (unsigned)__builtin_amdgcn_s_getreg((3 << 11) | 20) & 0xFu; }
#define XB_SPIN(cond, bar) do { unsigned _sp = 0; while (cond) { __builtin_amdgcn_s_sleep(1); \
    if ((++_sp & 255u) == 0u) { if (xb_ld(&(bar)[XB_TMO])) break; if (_sp > XB_SPIN_CAP) { atomicAdd(&(bar)[XB_TMO], 1u); break; } } } } while (0)

struct XcdBarrier {
    unsigned* bar; unsigned x;
    volatile LAS unsigned* st;
};

__device__ __forceinline__ XcdBarrier xcd_barrier_post(unsigned* bar, volatile LAS unsigned* st) {
    XcdBarrier b; b.bar = bar; b.x = xb_xcc_id(); b.st = st;
    if (threadIdx.x == 0) (void)xb_add(&bar[XB_XCNT(b.x)], 1u);
    return b;
}
__device__ __forceinline__ void xcd_barrier_complete(unsigned* bar, unsigned x, unsigned& nloc, unsigned& nx) {
    const unsigned G = gridDim.x * gridDim.y * gridDim.z;
    unsigned sum, cnt, mine, sp = 0u;
    for (;;) {
        sum = 0u; cnt = 0u; mine = 0u;
#pragma unroll
        for (unsigned j = 0; j < 16; ++j) { const unsigned c = xb_ld(&bar[XB_XCNT(j)]); sum += c; cnt += (c > 0u) ? 1u : 0u; mine = (j == x) ? c : mine; }
        if (sum == G) break;
        __builtin_amdgcn_s_sleep(1);
        if ((++sp & 255u) == 0u) { if (xb_ld(&bar[XB_TMO])) break; if (sp > XB_SPIN_CAP) { atomicAdd(&bar[XB_TMO], 1u); break; } }
    }
    nloc = mine > 0u ? mine : 1u; nx = cnt > 0u ? cnt : 1u;
}

__device__ __forceinline__ void xcd_barrier(const XcdBarrier& b) {
    asm volatile("s_waitcnt vmcnt(0)" ::: "memory");
    __syncthreads();
    if (threadIdx.x == 0) {
        unsigned* bar = b.bar;
        __builtin_amdgcn_s_waitcnt(0);
        unsigned nloc = b.st[0], nx = b.st[1];
        if (nloc == 0u) { xcd_barrier_complete(bar, b.x, nloc, nx); b.st[0] = nloc; b.st[1] = nx; }
        const unsigned old = xb_add(&bar[XB_XSUB(b.x)], 1u);
        const unsigned gen = old / nloc;
        if (old + 1u == (gen + 1u) * nloc) {
            __builtin_amdgcn_fence(__ATOMIC_RELEASE, "agent");
            asm volatile("s_waitcnt vmcnt(0)" ::: "memory");
            const unsigned og = xb_add(&bar[XB_TOP], 1u);
            const unsigned tg = og / nx;
            if (og + 1u == (tg + 1u) * nx) xb_add(&bar[XB_TOPGEN], 1u);
            else XB_SPIN(xb_ld(&bar[XB_TOPGEN]) == tg, bar);
            __builtin_amdgcn_fence(__ATOMIC_ACQUIRE, "agent");
            xb_add(&bar[XB_XGEN(b.x)], 1u);
            asm volatile("s_waitcnt vmcnt(0)" ::: "memory");
        } else {
            XB_SPIN(xb_ld(&bar[XB_XGEN(b.x)]) == gen, bar);
            __builtin_amdgcn_fence(__ATOMIC_ACQUIRE, "agent");
            asm volatile("s_waitcnt vmcnt(0)" ::: "memory");
        }
    }
    __syncthreads();
}
struct Args { const float* in[34]; float* out; unsigned char* ws; int ph_lo, ph_hi; };
enum { I_X = 0, I_P, I_RELB, I_GMIX, I_WIN, I_WGATE, I_BGATE, I_ARE, I_AIM, I_LOGDT, I_BRE, I_BIM, I_CRE, I_CIM, I_DSK, I_WGLU, I_BGLU, I_SINKS,
       I_WBRS, I_WBRA, I_WOUT, I_GFFN, I_WRG, I_BRG, I_WRE, I_BRE2, I_WEG, I_WEU, I_WED, I_GPLE, I_WPG, I_BPG, I_WPLE, I_GFIN };
constexpr int NPHASE = 14;

__device__ __forceinline__ void p0_transpose_item(const float* W, int N, bf16* WT, int ldt, int drow0, int k0, int n0, LAS float* scr, int lane) {
#pragma unroll 8
    for (int i = 0; i < 32; ++i) { const int kk = 2 * i + (lane >> 5); scr[kk * 33 + (lane & 31)] = W[(size_t)(k0 + kk) * N + n0 + (lane & 31)]; }
    LDS_WAIT(); asm volatile("" ::: "memory");
    const int c = lane & 7;
#pragma unroll
    for (int j = 0; j < 4; ++j) { const int n = (lane >> 3) + 8 * j; const LAS float* s = scr + (8 * c) * 33 + n;
        u32x4 o; o.x = pk2(s[0 * 33], s[1 * 33]); o.y = pk2(s[2 * 33], s[3 * 33]); o.z = pk2(s[4 * 33], s[5 * 33]); o.w = pk2(s[6 * 33], s[7 * 33]);
        *(u32x4*)(WT + (size_t)(drow0 + n) * ldt + k0 + 8 * c) = o; }
    LDS_WAIT(); asm volatile("" ::: "memory");
}
__device__ __forceinline__ void p0_tr_plain(const float* W, int K, int N, bf16* WT, int row_off, int item, LAS float* scr, int lane) {
    const int nblk = N / 32, kb = item / nblk, nb = item % nblk;
    p0_transpose_item(W, N, WT, K, row_off + 32 * nb, 64 * kb, 32 * nb, scr, lane);
}
struct Cplx { float re, im; };
__device__ __forceinline__ Cplx cmul(Cplx a, Cplx b) { return Cplx{a.re * b.re - a.im * b.im, a.re * b.im + a.im * b.re}; }
__device__ __forceinline__ Cplx apow(float are, float aim, float dt, int k) {
    const float mag = ex2((float)k * dt * are * LOG2E);
    const double rev = (double)k * (double)dt * (double)aim * 0.15915494309189535;
    const float fr = (float)(rev - __builtin_rint(rev));
    return Cplx{mag * __builtin_amdgcn_cosf(fr), mag * __builtin_amdgcn_sinf(fr)};
}
__device__ __forceinline__ void p0_ssm_params(const Args& a, LAS unsigned char* lds, int vb, int tid) {
    const int g = vb >> 3, sub = vb & 7;
    LAS float* cfr = (LAS float*)lds; LAS float* cfi = cfr + 64; LAS float* apr = cfr + 128; LAS float* api = apr + 17 * 64;
    const float dt = ex2(a.in[I_LOGDT][g] * LOG2E);
    for (int idx = tid; idx < 64 + 17 * 64; idx += 512) {
        if (idx < 64) {
            const int p = idx; const float are = a.in[I_ARE][g * 64 + p], aim = a.in[I_AIM][g * 64 + p];
            const Cplx z{are * dt, aim * dt}; const float z2 = z.re * z.re + z.im * z.im; Cplx cf;
            if (z2 < 0.01f) {
                Cplx s{1.f / 120.f, 0.f}; s = cmul(s, z); s.re += 1.f / 24.f; s = cmul(s, z); s.re += 1.f / 6.f; s = cmul(s, z); s.re += 0.5f; s = cmul(s, z); s.re += 1.f;
                cf = Cplx{s.re * dt, s.im * dt};
            } else {
                const Cplx ab = apow(are, aim, dt, 1); const Cplx num{ab.re - 1.f, ab.im}; const float inv = 1.f / (are * are + aim * aim);
                cf = Cplx{(num.re * are + num.im * aim) * inv, (num.im * are - num.re * aim) * inv};
            }
            cfr[p] = cf.re; cfi[p] = cf.im;
        } else {
            const int k = (idx - 64) >> 6, p = (idx - 64) & 63;
            const Cplx v = apow(a.in[I_ARE][g * 64 + p], a.in[I_AIM][g * 64 + p], dt, k);
            apr[k * 64 + p] = v.re; api[k * 64 + p] = v.im;
        }
    }
    __syncthreads();
    bf16* Bs = (bf16*)(a.ws + WS_BSSM); bf16* M1 = (bf16*)(a.ws + WS_M1T); float* A16 = (float*)(a.ws + WS_A16);
    const float* bre = a.in[I_BRE]; const float* bim = a.in[I_BIM]; const float* cre = a.in[I_CRE]; const float* cim = a.in[I_CIM];
    {
        const int tau = 2 * sub + (tid >> 8), c = (tid >> 4) & 15, c2 = tid & 15; float acc = 0.f;
        for (int p = 0; p < 64; ++p) {
            const Cplx w = cmul(Cplx{apr[tau * 64 + p], api[tau * 64 + p]}, Cplx{cfr[p], cfi[p]});
            const Cplx v = cmul(w, Cplx{bre[(g * 64 + p) * 16 + c2], bim[(g * 64 + p) * 16 + c2]});
            acc += cre[(g * 16 + c) * 64 + p] * v.re - cim[(g * 16 + c) * 64 + p] * v.im;
        }
        if (tau == 0 && c == c2) acc += a.in[I_DSK][g * 16 + c];
        const bf16 hv = (bf16)(pk2(acc, 0.f) & 0xffffu);
        for (int s = tau; s < 16; ++s) Bs[(size_t)(g * 256 + s * 16 + c) * 384 + (s - tau) * 16 + c2] = hv;
        if (tau > 0) for (int s = 0; s + tau < 16; ++s) Bs[(size_t)(g * 256 + s * 16 + c) * 384 + (s + tau) * 16 + c2] = 0;
    }
    {
        const int n = 32 * sub + (tid >> 4), pg = tid & 15, s = n >> 4, c = n & 15; float v[8];
#pragma unroll
        for (int q = 0; q < 4; ++q) { const int p = 4 * pg + q; const Cplx w = cmul(Cplx{cre[(g * 16 + c) * 64 + p], cim[(g * 16 + c) * 64 + p]}, Cplx{apr[(s + 1) * 64 + p], api[(s + 1) * 64 + p]});
            v[2 * q] = w.re; v[2 * q + 1] = -w.im; }
        u32x4 o; o.x = pk2(v[0], v[1]); o.y = pk2(v[2], v[3]); o.z = pk2(v[4], v[5]); o.w = pk2(v[6], v[7]);
        *(u32x4*)(Bs + (size_t)(g * 256 + n) * 384 + 256 + 8 * pg) = o;
    }
    {
        const int p = 8 * sub + (tid >> 6), s = (tid >> 2) & 15, cq = tid & 3;
        const Cplx w = cmul(Cplx{apr[(15 - s) * 64 + p], api[(15 - s) * 64 + p]}, Cplx{cfr[p], cfi[p]}); float vr[4], vi[4];
#pragma unroll
        for (int i = 0; i < 4; ++i) { const int c = 4 * cq + i; const Cplx v = cmul(w, Cplx{bre[(g * 64 + p) * 16 + c], bim[(g * 64 + p) * 16 + c]}); vr[i] = v.re; vi[i] = v.im; }
        u32x2 o; o.x = pk2(vr[0], vr[1]); o.y = pk2(vr[2], vr[3]); *(u32x2*)(M1 + (size_t)(g * 128 + 2 * p) * 256 + s * 16 + 4 * cq) = o;
        o.x = pk2(vi[0], vi[1]); o.y = pk2(vi[2], vi[3]); *(u32x2*)(M1 + (size_t)(g * 128 + 2 * p + 1) * 256 + s * 16 + 4 * cq) = o;
    }
    if (sub == 0 && tid < 64) { A16[(g * 64 + tid) * 2] = apr[16 * 64 + tid]; A16[(g * 64 + tid) * 2 + 1] = api[16 * 64 + tid]; }
    __syncthreads();
}
__device__ __forceinline__ void rms_row_to_bf16(const float* xrow, const float* gain, bf16* orow, int lane) {
    const f32x4* xr = (const f32x4*)xrow + lane; f32x4 v[4]; float s = 0.f;
#pragma unroll
    for (int j = 0; j < 4; ++j) { v[j] = xr[64 * j]; s += (v[j][0] * v[j][0] + v[j][1] * v[j][1]) + (v[j][2] * v[j][2] + v[j][3] * v[j][3]); }
    const float rs = __builtin_amdgcn_rsqf(wave_sum(s) * (1.0f / 1024.0f) + RMS_EPS);
    u32x2* o8 = (u32x2*)orow + lane;
#pragma unroll
    for (int j = 0; j < 4; ++j) { const f32x4 gq = ((const f32x4*)gain)[lane + 64 * j]; u32x2 o; o.x = pk2(v[j][0] * rs * gq[0], v[j][1] * rs * gq[1]); o.y = pk2(v[j][2] * rs * gq[2], v[j][3] * rs * gq[3]); o8[64 * j] = o; }
}
__device__ __forceinline__ void p0_prologue(const Args& a, LAS unsigned char* lds, int tid, int lane, int wave) {
    const int G = gridDim.x;
    for (int vb = blockIdx.x; vb < 256; vb += G) p0_ssm_params(a, lds, vb, tid);
    {
        bf16* Wr = (bf16*)(a.ws + WS_WR); const float* wrg = a.in[I_WRG]; const float* wre = a.in[I_WRE];
        for (int e = (blockIdx.x * 512 + tid) * 2; e < 256 * 1024; e += G * 1024) { const int n = e >> 10, k = e & 1023; float v0 = 0.f, v1 = 0.f;
            if (n < 4) { v0 = wrg[k * 4 + n]; v1 = wrg[(k + 1) * 4 + n]; } else if (n < 36) { v0 = wre[k * 32 + n - 4]; v1 = wre[(k + 1) * 32 + n - 4]; }
            *(unsigned*)(Wr + e) = pk2(v0, v1); }
    }
    LAS float* scr = (LAS float*)(lds + wave * 16384);
    const int gw = blockIdx.x * NWAVES + wave, NGW = G * NWAVES;
    bf16* Wcat = (bf16*)(a.ws + WS_WCAT);
    constexpr int I_IN = 16 * 40, I_GATE = 16 * 64, I_GLU = 8 * 16, I_BR = 8 * 32, I_SQ = 16 * 32, I_PLE = 4 * 32, I_EXP = 256;
    constexpr int NITEMS = I_IN + I_GATE + I_GLU + 2 * I_BR + 2 * I_SQ + I_PLE + 96 * I_EXP;
    for (int it = gw; it < NITEMS; it += NGW) {
        int r = it;
        if (r < I_IN) { p0_tr_plain(a.in[I_WIN], 1024, 1280, Wcat, 0, r, scr, lane); continue; } r -= I_IN;
        if (r < I_GATE) { p0_tr_plain(a.in[I_WGATE], 1024, 2048, Wcat, 1280, r, scr, lane); continue; } r -= I_GATE;
        if (r < I_GLU) { p0_tr_plain(a.in[I_WGLU], 512, 512, (bf16*)(a.ws + WS_WGLU), 0, r, scr, lane); continue; } r -= I_GLU;
        if (r < I_BR) { p0_tr_plain(a.in[I_WBRS], 512, 1024, (bf16*)(a.ws + WS_WA), 0, r, scr, lane); continue; } r -= I_BR;
        if (r < I_BR) { p0_tr_plain(a.in[I_WBRA], 512, 1024, (bf16*)(a.ws + WS_WB), 0, r, scr, lane); continue; } r -= I_BR;
        if (r < I_SQ) { p0_tr_plain(a.in[I_WOUT], 1024, 1024, (bf16*)(a.ws + WS_WOUT), 0, r, scr, lane); continue; } r -= I_SQ;
        if (r < I_SQ) { p0_tr_plain(a.in[I_WPG], 1024, 1024, (bf16*)(a.ws + WS_WPG), 0, r, scr, lane); continue; } r -= I_SQ;
        if (r < I_PLE) { p0_tr_plain(a.in[I_WPLE], 256, 1024, (bf16*)(a.ws + WS_WPLE), 0, r, scr, lane); continue; } r -= I_PLE;
        const int em = r >> 8, it2 = r & 255, e = em / 3, which = em % 3;
        if (which == 2) {
            p0_tr_plain(a.in[I_WED] + (size_t)e * 512 * 1024, 512, 1024, (bf16*)(a.ws + WS_WD) + (size_t)e * 1024 * 512, 0, it2, scr, lane);
        } else {
            const int kb = it2 >> 4, nb = it2 & 15, n0 = 32 * nb;
            p0_transpose_item(a.in[which == 0 ? I_WEG : I_WEU] + (size_t)e * 1024 * 512, 512, (bf16*)(a.ws + WS_WGU) + (size_t)e * 1024 * 1024, 1024, 256 * (n0 >> 7) + 128 * which + (n0 & 127), 64 * kb, n0, scr, lane);
        }
    }
    bf16* H = (bf16*)(a.ws + WS_R1);
    for (int m = gw; m < TOK; m += NGW) rms_row_to_bf16(a.in[I_X] + (size_t)m * 1024, a.in[I_GMIX], H + (size_t)m * 1024, lane);
    {
        const f32x4* P = (const f32x4*)a.in[I_P]; u32x4* PB = (u32x4*)(a.ws + WS_PB);
        for (int i = gw * 64 + lane; i < TOK * 256 / 8; i += NGW * 64) { const f32x4 v0 = P[2 * i], v1 = P[2 * i + 1]; PB[i] = pack8(v0, v1); }
    }
}

__device__ __forceinline__ void ssm_scan_unit(const Args& a, LAS unsigned char* lds, int unit, int tid, int lane, int wave) {
    const int g = unit >> 3, b = unit & 7, r32 = lane & 31, hi = lane >> 5;
    bf16* Arow = (bf16*)(a.ws + WS_ASSM) + (size_t)(g * 2048 + b * 256) * 384;
    const bf16* M1 = (const bf16*)(a.ws + WS_M1T) + (size_t)g * 128 * 256;
    LAS float* sloc = (LAS float*)lds;
    LAS float* segend = (LAS float*)(lds + EXTRA_OFF + 2048);
    {
        f32x16 acc[4];
#pragma unroll
        for (int nt = 0; nt < 4; ++nt)
#pragma unroll
            for (int i = 0; i < 16; ++i) acc[nt][i] = 0.f;
        const bf16* ap = Arow + (size_t)(32 * wave + r32) * 384 + 8 * hi;
        const bf16* bp = M1 + (size_t)r32 * 256 + 8 * hi;
#pragma unroll 4
        for (int ks = 0; ks < 16; ++ks) {
            const bf16x8 af = *(const bf16x8*)(ap + 16 * ks);
#pragma unroll
            for (int nt = 0; nt < 4; ++nt) { const bf16x8 bfr = *(const bf16x8*)(bp + (size_t)nt * 32 * 256 + 16 * ks); acc[nt] = __builtin_amdgcn_mfma_f32_32x32x16_bf16(af, bfr, acc[nt], 0, 0, 0); }
        }
#pragma unroll
        for (int nt = 0; nt < 4; ++nt)
#pragma unroll
            for (int i = 0; i < 16; ++i) { const int j = 32 * wave + (i & 3) + 8 * (i >> 2) + 4 * hi; sloc[j * 128 + nt * 32 + r32] = acc[nt][i]; }
    }
    __syncthreads();
    const int p = tid & 63, seg = tid >> 6;
    const float* A16 = (const float*)(a.ws + WS_A16) + (g * 64 + p) * 2;
    const Cplx a16{A16[0], A16[1]};
    Cplx st{0.f, 0.f};
    for (int j = seg * 32; j < seg * 32 + 32; ++j) { const Cplx s{sloc[j * 128 + 2 * p], sloc[j * 128 + 2 * p + 1]}; st = cmul(a16, st); st.re += s.re; st.im += s.im; }
    segend[(seg * 64 + p) * 2] = st.re; segend[(seg * 64 + p) * 2 + 1] = st.im;
    Cplx a512 = a16;
#pragma unroll
    for (int i = 0; i < 5; ++i) a512 = cmul(a512, a512);
    __syncthreads();
    st = Cplx{0.f, 0.f};
    for (int s2 = 0; s2 < seg; ++s2) { st = cmul(a512, st); st.re += segend[(s2 * 64 + p) * 2]; st.im += segend[(s2 * 64 + p) * 2 + 1]; }
    for (int j = seg * 32; j < seg * 32 + 32; ++j) {
        *(unsigned*)(Arow + (size_t)j * 384 + 256 + 2 * p) = pk2(st.re, st.im);
        const Cplx s{sloc[j * 128 + 2 * p], sloc[j * 128 + 2 * p + 1]}; st = cmul(a16, st); st.re += s.re; st.im += s.im;
    }
    __syncthreads();
}

__device__ const unsigned char T5_BUCKET[128] = {0, 1, 2, 3, 4, 5, 6, 7, 8, 9, 10, 11, 12, 13, 14, 15, 16, 16, 16, 17, 17, 18, 18, 18, 19, 19, 19, 20, 20, 20, 20, 21, 21, 21, 21, 22, 22, 22, 22, 22, 23, 23, 23, 23, 23, 23, 24, 24, 24, 24, 24, 24, 25, 25, 25, 25, 25, 25, 25, 26, 26, 26, 26, 26, 26, 26, 26, 27, 27, 27, 27, 27, 27, 27, 27, 27, 27, 28, 28, 28, 28, 28, 28, 28, 28, 28, 28, 29, 29, 29, 29, 29, 29, 29, 29, 29, 29, 29, 29, 30, 30, 30, 30, 30, 30, 30, 30, 30, 30, 30, 30, 30, 30, 31, 31, 31, 31, 31, 31, 31, 31, 31, 31, 31, 31, 31, 31, 31};
__device__ __forceinline__ void attn_unit(const Args& a, LAS unsigned char* lds, int unit, int tid_in, int lane_in, int wave) {
    int tid = tid_in; asm volatile("" : "+v"(tid)); const int lane = tid & 63;
    const int b = unit >> 6, blk = (unit >> 1) & 31, kvh = unit & 1, r32 = lane & 31, hi = lane >> 5;
    const bf16* qkv = (const bf16*)(a.ws + WS_QKV); bf16* yatt = (bf16*)(a.ws + WS_YATT);
    const size_t tok0 = (size_t)b * SEQ + (size_t)blk * 128;
    LAS unsigned char* Kl = lds; LAS unsigned char* Vl = lds + 32768; LAS float* bl = (LAS float*)(lds + 65536);
    const u32x4 zero4 = {0u, 0u, 0u, 0u};
#pragma unroll
    for (int i = 0; i < 4; ++i) { const int key = tid & 255, ch = (tid >> 8) + 2 * i;
        u32x4 v = zero4; if (blk > 0 || key >= 128) v = *(const u32x4*)(qkv + (tok0 - 128 + key) * 768 + 512 + kvh * 64 + ch * 8);
        *(LAS u32x4*)(Kl + (ch * 256 + key) * 16) = v; }
#pragma unroll
    for (int i = 0; i < 4; ++i) { const int pidx = tid + 512 * i, key = pidx >> 3, rem = pidx & 7, dh = rem >> 2, q4 = rem & 3;
        u32x4 v = zero4; if (blk > 0 || key >= 128) v = *(const u32x4*)(qkv + (tok0 - 128 + key) * 768 + 640 + kvh * 64 + dh * 32 + q4 * 8);
        *(LAS u32x4*)(Vl + dh * 16384 + key * 64 + q4 * 16) = v; }
    for (int idx = tid; idx < 4 * 192; idx += 512) { const int hl = idx / 192, rel = idx % 192 - 32;
        bl[idx] = (rel >= 0 && rel < 128) ? a.in[I_RELB][T5_BUCKET[rel] * 8 + kvh * 4 + hl] * LOG2E : -INFINITY; }
    __syncthreads();
    const int hl = wave >> 1, head = kvh * 4 + hl;
    const float sink2 = a.in[I_SINKS][head] * LOG2E;
    const LAS float* blane = bl + hl * 192 + 32 + 128 + r32 - 4 * hi;
    const int vlane = ((lane >> 4) & 1) * 32 + (lane & 3) * 8 + (4 * hi + ((lane & 15) >> 2)) * 64;
    for (int qb = 0; qb < 2; ++qb) {
        const int qi = (wave & 1) * 2 + qb;
        const size_t tq = tok0 + qi * 32 + r32;
        bf16x8 qr[4];
#pragma unroll
        for (int d0 = 0; d0 < 4; ++d0) qr[d0] = *(const bf16x8*)(qkv + tq * 768 + head * 64 + d0 * 16 + hi * 8);
        f32x16 p[5];
        float mx = sink2;
#pragma unroll
        for (int kt = 0; kt < 5; ++kt) {
#pragma unroll
            for (int i = 0; i < 16; ++i) p[kt][i] = 0.f;
            const LAS unsigned char* kp = Kl + (hi * 256 + 32 * (qi + kt) + r32) * 16;
#pragma unroll
            for (int d0 = 0; d0 < 4; ++d0) { const bf16x8 kf = *(const LAS bf16x8*)(kp + d0 * 8192); p[kt] = __builtin_amdgcn_mfma_f32_32x32x16_bf16(kf, qr[d0], p[kt], 0, 0, 0); }
            const bool tile_ok = (blk > 0) || (qi + kt >= 4);
#pragma unroll
            for (int i = 0; i < 16; ++i) { const float bq = blane[-32 * kt - ((i & 3) + 8 * (i >> 2))];
                const float sv = tile_ok ? p[kt][i] + bq : -INFINITY; p[kt][i] = sv; mx = fmaxf(mx, sv); }
            __builtin_amdgcn_sched_barrier(0);
        }
        mx = fmaxf(mx, __shfl_xor(mx, 32));
        float sum = 0.f;
        f32x16 o[2];
#pragma unroll
        for (int dh = 0; dh < 2; ++dh)
#pragma unroll
            for (int i = 0; i < 16; ++i) o[dh][i] = 0.f;
#pragma unroll
        for (int kt = 0; kt < 5; ++kt) {
#pragma unroll
            for (int i = 0; i < 16; ++i) { const float e = ex2(p[kt][i] - mx); p[kt][i] = e; sum += e; }
#pragma unroll
            for (int s2 = 0; s2 < 2; ++s2) {
                u32x4 pw; pw.x = pk2(p[kt][8 * s2 + 0], p[kt][8 * s2 + 1]); pw.y = pk2(p[kt][8 * s2 + 2], p[kt][8 * s2 + 3]); pw.z = pk2(p[kt][8 * s2 + 4], p[kt][8 * s2 + 5]); pw.w = pk2(p[kt][8 * s2 + 6], p[kt][8 * s2 + 7]);
                const bf16x8 pa = __builtin_bit_cast(bf16x8, pw);
#pragma unroll
                for (int dh = 0; dh < 2; ++dh) { LAS unsigned char* vp = Vl + dh * 16384 + (32 * (qi + kt) + 16 * s2) * 64 + vlane;
                    const v4i16_t lo = __builtin_amdgcn_ds_read_tr16_b64_v4i16((LAS v4i16_t*)vp), hh = __builtin_amdgcn_ds_read_tr16_b64_v4i16((LAS v4i16_t*)(vp + 512));
                    const bf16x8 vb = (bf16x8){lo[0], lo[1], lo[2], lo[3], hh[0], hh[1], hh[2], hh[3]};
                    o[dh] = __builtin_amdgcn_mfma_f32_32x32x16_bf16(pa, vb, o[dh], 0, 0, 0); }
            }
            __builtin_amdgcn_sched_barrier(0);
        }
        sum += __shfl_xor(sum, 32); sum += ex2(sink2 - mx);
        const float rinv = 1.0f / sum;
#pragma unroll
        for (int i = 0; i < 16; ++i) { const int cr = (i & 3) + 8 * (i >> 2) + 4 * hi; const float ri = __shfl(rinv, cr);
            bf16* orow = yatt + (tok0 + qi * 32 + cr) * 512 + head * 64 + r32;
            orow[0] = (bf16)(pk2(o[0][i] * ri, 0.f) & 0xffffu); orow[32] = (bf16)(pk2(o[1][i] * ri, 0.f) & 0xffffu); }
        __builtin_amdgcn_sched_barrier(0);
    }
    __syncthreads();
}

__device__ __forceinline__ void moe_offsets(const Args& a, LAS int* pad, int tid) {
    gu32* ctl = (gu32*)(a.ws + WS_CTL);
    if (tid == 0) { int acc = 0;
        for (int e = 0; e < 32; ++e) { pad[e] = acc; const int c = (int)__hip_atomic_load(ctl + CW_CNT + e, RLX_AGENT); acc += ((c + 255) >> 8) << 8; }
        pad[32] = acc; }
    __syncthreads();
}
__device__ __forceinline__ void p8_scatter(const Args& a, LAS unsigned char* lds, int tid, int lane, int wave) {
    LAS int* pad = (LAS int*)(lds + EXTRA_OFF + 8192);
    moe_offsets(a, pad, tid);
    gu32* ctl = (gu32*)(a.ws + WS_CTL);
    if (blockIdx.x == 0) { const int nblk = pad[32] >> 8; if (tid == 0) ctl[CW_BLK] = (unsigned)nblk;
        for (int rb = tid; rb < nblk; rb += 512) { int e = 0; for (int q = 1; q < 32; ++q) if ((rb << 8) >= pad[q]) e = q;
            ctl[CW_BLK + 1 + rb] = (unsigned)e; } }
    const int* slot_e = (const int*)(a.ws + WS_SLOT_E); const int* slot_pos = (const int*)(a.ws + WS_SLOT_POS); const float* slot_w = (const float*)(a.ws + WS_SLOT_W);
    int* slot_dest = (int*)(a.ws + WS_SLOT_DEST); float* dw = (float*)(a.ws + WS_DEST_W); float* drs = (float*)(a.ws + WS_DEST_RSTD);
    const float* rstd1 = (const float*)(a.ws + WS_RSTD1);
    const bf16* xg = (const bf16*)(a.ws + WS_R1); bf16* xd = (bf16*)(a.ws + WS_XD);
    const int gw = blockIdx.x * NWAVES + wave, NGW = gridDim.x * NWAVES;
    for (int sl = gw; sl < NSLOT; sl += NGW) { const int t = sl >> 1, e = slot_e[sl], dest = pad[e] + slot_pos[sl];
        const u32x4* src = (const u32x4*)(xg + (size_t)t * 1024); u32x4* dst = (u32x4*)(xd + (size_t)dest * 1024);
        const u32x4 v0 = src[lane], v1 = src[lane + 64]; dst[lane] = v0; dst[lane + 64] = v1;
        if (lane == 0) { slot_dest[sl] = dest; dw[dest] = slot_w[sl]; drs[dest] = rstd1[t]; } }
}
__device__ __forceinline__ void moe_load_blk(const Args& a, LAS int* blk, int tid) {
    gu32* ctl = (gu32*)(a.ws + WS_CTL);
    for (int i = tid; i < 1 + MAXBLK; i += 512) blk[i] = (int)__hip_atomic_load(ctl + CW_BLK + i, RLX_AGENT);
    __syncthreads();
}
__device__ __forceinline__ void p11_combine(const Args& a, int lane, int wave) {
    const int gw = blockIdx.x * NWAVES + wave, NGW = gridDim.x * NWAVES;
    const int* slot_dest = (const int*)(a.ws + WS_SLOT_DEST); const bf16* yd = (const bf16*)(a.ws + WS_XD); bf16* x2g = (bf16*)(a.ws + WS_ACT); float* rstd2 = (float*)(a.ws + WS_RSTD2);
    const float* gain = a.in[I_GPLE];
    for (int t = gw; t < TOK; t += NGW) { const int d0 = slot_dest[2 * t], d1 = slot_dest[2 * t + 1];
        f32x4* xr = (f32x4*)(a.out + (size_t)t * 1024) + lane; const u32x2* y0 = (const u32x2*)(yd + (size_t)d0 * 1024) + lane; const u32x2* y1 = (const u32x2*)(yd + (size_t)d1 * 1024) + lane;
        f32x4 v[4]; float s = 0.f;
#pragma unroll
        for (int j = 0; j < 4; ++j) { v[j] = xr[64 * j]; const u32x2 p0 = y0[64 * j], p1 = y1[64 * j];
            v[j][0] += bflo(p0.x) + bflo(p1.x); v[j][1] += bfhi(p0.x) + bfhi(p1.x); v[j][2] += bflo(p0.y) + bflo(p1.y); v[j][3] += bfhi(p0.y) + bfhi(p1.y);
            s += (v[j][0] * v[j][0] + v[j][1] * v[j][1]) + (v[j][2] * v[j][2] + v[j][3] * v[j][3]); xr[64 * j] = v[j]; }
        const float tot = wave_sum(s); if (lane == 0) rstd2[t] = __builtin_amdgcn_rsqf(tot * (1.0f / 1024.0f) + RMS_EPS);
        u32x2* o8 = (u32x2*)(x2g + (size_t)t * 1024) + lane;
#pragma unroll
        for (int j = 0; j < 4; ++j) { const f32x4 gq = ((const f32x4*)gain)[lane + 64 * j]; u32x2 o; o.x = pk2(v[j][0] * gq[0], v[j][1] * gq[1]); o.y = pk2(v[j][2] * gq[2], v[j][3] * gq[3]); o8[64 * j] = o; } }
}
__device__ __forceinline__ void p13_final(const Args& a, int lane, int wave) {
    const int gw = blockIdx.x * NWAVES + wave, NGW = gridDim.x * NWAVES; const float* gain = a.in[I_GFIN];
    for (int t = gw; t < TOK; t += NGW) { f32x4* xr = (f32x4*)(a.out + (size_t)t * 1024) + lane; f32x4 v[4]; float s = 0.f;
#pragma unroll
        for (int j = 0; j < 4; ++j) { v[j] = xr[64 * j]; s += (v[j][0] * v[j][0] + v[j][1] * v[j][1]) + (v[j][2] * v[j][2] + v[j][3] * v[j][3]); }
        const float rs = __builtin_amdgcn_rsqf(wave_sum(s) * (1.0f / 1024.0f) + RMS_EPS);
#pragma unroll
        for (int j = 0; j < 4; ++j) { const f32x4 gq = ((const f32x4*)gain)[lane + 64 * j]; xr[64 * j] = v[j] * rs * gq; } }
}

__global__ void __launch_bounds__(NWAVES * 64, 2) fwd_kernel(Args args) {
    extern __shared__ __attribute__((aligned(16))) unsigned char lds_raw[];
    LAS unsigned char* lds = (LAS unsigned char*)lds_raw;
#define FRESH_TID() int tid_f = threadIdx.x; asm volatile("" : "+v"(tid_f)); const int tid = tid_f, lane = tid & 63, wave = __builtin_amdgcn_readfirstlane(tid >> 6); (void)lane; (void)wave
    const int G = gridDim.x, bx = blockIdx.x;
    const int vcu = (G % 8 == 0) ? (bx % 8) * (G / 8) + bx / 8 : bx;
    unsigned char* ws = args.ws;
    gu32* ctl = (gu32*)(ws + WS_CTL);
    for (int u = threadIdx.x; u < (LDS_BYTES - LDSCTL_OFF) / 4; u += NWAVES * 64) ((LAS unsigned*)(lds + LDSCTL_OFF))[u] = 0u;
    __syncthreads();
    const int lo = args.ph_lo, hi = args.ph_hi;
    const bool use_bar = (hi - lo) > 1;
    XcdBarrier bar; bar.bar = (unsigned*)(ctl + CW_BAR); bar.x = 0; bar.st = nullptr;
    if (use_bar) bar = xcd_barrier_post((unsigned*)(ctl + CW_BAR), (volatile LAS unsigned*)(lds + MISC_OFF) + 8);
#ifndef PHASE_MASK
#define PHASE_MASK 0x3fff
#endif
#define IN(k) (((PHASE_MASK >> (k)) & 1) && lo <= (k) && (k) < hi)
#define SEAM(k) do { if (IN(k) && IN((k) + 1)) xcd_barrier(bar); } while (0)

    bf16* const R1 = (bf16*)(ws + WS_R1);

    if (IN(0)) { FRESH_TID(); p0_prologue(args, lds, tid, lane, wave); }
    SEAM(0);
    if (IN(1)) {
        pg8::Gemm g{R1, (const bf16*)(ws + WS_WCAT), TOK, 3328, 1024}; pg8::StaticOrder S; S.init(TOK, 3328, G, bx);
        Epi1 E{(bf16*)(ws + WS_ASSM), (bf16*)(ws + WS_QKV), (bf16*)(ws + WS_GATES), args.in[I_BGATE]};
        pg8::gemm_phase<Epi1, pg8::StaticOrder, true, true>(lds + RING_OFF, g, S, E);
    }
    SEAM(1);
    if (IN(2)) {
        FRESH_TID();
#ifndef NO_SCAN
        for (int u = vcu; u < 256; u += G) ssm_scan_unit(args, lds, u, tid, lane, wave);
#endif
#ifndef NO_ATTN
        for (int u = vcu; u < 512; u += G) attn_unit(args, lds, u, tid, lane, wave);
#endif
    }
    SEAM(2);
    if (IN(3)) {
        {
            pg8::Gemm g{(const bf16*)(ws + WS_ASSM), (const bf16*)(ws + WS_BSSM), 65536, 8192, 384};
#ifndef NO_SSMG
            OneUnit S{vcu, vcu >> 3, vcu < 256};
            EpiSsm E{(bf16*)(ws + WS_YG)};
            pg8::gemm_phase<EpiSsm, OneUnit, false, true>(lds + RING_OFF, g, S, E);
#endif
        }
        {
#ifndef NO_BRB
            pg8::Gemm g{(const bf16*)(ws + WS_YATT), (const bf16*)(ws + WS_WB), TOK, 1024, 512}; pg8::StaticOrder S; S.init(TOK, 1024, G, bx);
            EpiBranch<false> E{(const bf16*)(ws + WS_GATES), 1024, nullptr, R1};
            pg8::gemm_phase<EpiBranch<false>, pg8::StaticOrder, true, true>(lds + RING_OFF, g, S, E);
#endif
        }
    }
    SEAM(3);
    if (IN(4)) {
        pg8::Gemm g{(const bf16*)(ws + WS_YG), (const bf16*)(ws + WS_WGLU), TOK, 512, 512}; pg8::StaticOrder S; S.init(TOK, 512, G, bx);
        EpiGlu E{(const bf16*)(ws + WS_YG), (bf16*)(ws + WS_YATT), args.in[I_BGLU]};
        pg8::gemm_phase<EpiGlu, pg8::StaticOrder, true, true>(lds + RING_OFF, g, S, E);
    }
    SEAM(4);
    if (IN(5)) {
        pg8::Gemm g{(const bf16*)(ws + WS_YATT), (const bf16*)(ws + WS_WA), TOK, 1024, 512}; pg8::StaticOrder S; S.init(TOK, 1024, G, bx);
        EpiBranch<true> E{(const bf16*)(ws + WS_GATES), 0, R1, (bf16*)(ws + WS_MERGED)};
        pg8::gemm_phase<EpiBranch<true>, pg8::StaticOrder, true, true>(lds + RING_OFF, g, S, E);
    }
    SEAM(5);
    if (IN(6)) {
        pg8::Gemm g{(const bf16*)(ws + WS_MERGED), (const bf16*)(ws + WS_WOUT), TOK, 1024, 1024}; pg8::StaticOrder S; S.init(TOK, 1024, G, bx);
        EpiWout E{args.in[I_X], args.out, R1, args.in[I_GFFN], (float*)(ws + WS_RSS1)};
        pg8::gemm_phase<EpiWout, pg8::StaticOrder, true, true>(lds + RING_OFF, g, S, E);
    }
    SEAM(6);
    if (IN(7)) {
        const int half = G / 2;
        if (bx < half) {
            pg8::Gemm g{R1, (const bf16*)(ws + WS_WR), TOK, 256, 1024};
            EpiRouter E{(const float*)(ws + WS_RSS1), (float*)(ws + WS_RSTD1), args.in[I_BRG], args.in[I_BRE2], (unsigned*)(ctl + CW_CNT), (int*)(ws + WS_SLOT_E), (int*)(ws + WS_SLOT_POS), (float*)(ws + WS_SLOT_W)};
            for (int pm = bx; pm < 128; pm += half) { OneUnit S{pm, 0, true}; pg8::gemm_phase<EpiRouter, OneUnit, false, true>(lds + RING_OFF, g, S, E); __syncthreads(); }
        } else {
            pg8::Gemm g{(const bf16*)(ws + WS_PB), (const bf16*)(ws + WS_WPLE), TOK, 1024, 256}; pg8::StaticOrder S; S.init(TOK, 1024, G - half, bx - half);
            EpiPlain E{(bf16*)(ws + WS_PP), 1024};
            pg8::gemm_phase<EpiPlain, pg8::StaticOrder, true, true>(lds + RING_OFF, g, S, E);
        }
    }
    SEAM(7);
    if (IN(8)) { FRESH_TID(); p8_scatter(args, lds, tid, lane, wave); }
    SEAM(8);
    if (IN(9)) {
        FRESH_TID(); LAS int* blk = (LAS int*)(lds + EXTRA_OFF); moe_load_blk(args, blk, tid);
        pg8::Gemm g{(const bf16*)(ws + WS_XD), (const bf16*)(ws + WS_WGU), MAXROWS, 32 * 1024, 1024};
        MoeOrder S{__builtin_amdgcn_readfirstlane(blk[0]) * 4, G, vcu, blk};
        EpiMoe1 E{(bf16*)(ws + WS_ACT), (const float*)(ws + WS_DEST_RSTD)};
        pg8::gemm_phase<EpiMoe1, MoeOrder, true, true>(lds + RING_OFF, g, S, E);
    }
    SEAM(9);
    if (IN(10)) {
        FRESH_TID(); LAS int* blk = (LAS int*)(lds + EXTRA_OFF); moe_load_blk(args, blk, tid);
        pg8::Gemm g{(const bf16*)(ws + WS_ACT), (const bf16*)(ws + WS_WD), MAXROWS, 32 * 1024, 512};
        MoeOrder S{__builtin_amdgcn_readfirstlane(blk[0]) * 4, G, vcu, blk};
        EpiMoe2 E{(bf16*)(ws + WS_XD), (const float*)(ws + WS_DEST_W)};
        pg8::gemm_phase<EpiMoe2, MoeOrder, true, true>(lds + RING_OFF, g, S, E);
    }
    SEAM(10);
    if (IN(11)) { FRESH_TID(); p11_combine(args, lane, wave); }
    SEAM(11);
    if (IN(12)) {
        pg8::Gemm g{(const bf16*)(ws + WS_ACT), (const bf16*)(ws + WS_WPG), TOK, 1024, 1024}; pg8::StaticOrder S; S.init(TOK, 1024, G, bx);
        EpiPle E{args.out, (const bf16*)(ws + WS_PP), (const float*)(ws + WS_RSTD2), args.in[I_BPG]};
        pg8::gemm_phase<EpiPle, pg8::StaticOrder, true, true>(lds + RING_OFF, g, S, E);
    }
    SEAM(12);
    if (IN(13)) { FRESH_TID(); p13_final(args, lane, wave); }

#ifdef DUMP_LEVEL
    if (lo <= 14 && 14 < hi) {
        const size_t n = (size_t)TOK * 1024;
        for (size_t i = (size_t)bx * 512 + threadIdx.x; i < n; i += (size_t)G * 512) {
            float v = 0.f;
            auto B = [&](size_t off, size_t cnt) { const bf16* p = (const bf16*)(ws + off); return __uint_as_float((unsigned)p[i % cnt] << 16); };
            if (DUMP_LEVEL == 0) { v += B(WS_R1, n) + B(WS_WCAT, 3328 * 1024) + B(WS_WGU, 32u * 1024 * 1024) + B(WS_WD, 16u * 1024 * 1024) + B(WS_BSSM, 8192 * 384) + B(WS_M1T, 32 * 128 * 256)
                                      + B(WS_WR, 256 * 1024) + B(WS_WOUT, 1024 * 1024) + B(WS_WPG, 1024 * 1024) + B(WS_WA, 512 * 1024) + B(WS_WB, 512 * 1024) + B(WS_WGLU, 512 * 512) + B(WS_WPLE, 256 * 1024) + B(WS_PB, (size_t)TOK * 256)
                                      + ((const float*)(ws + WS_A16))[i % 4096]; }
            if (DUMP_LEVEL >= 1) { v += B(WS_QKV, (size_t)TOK * 768) + B(WS_GATES, n) + B(WS_GATES + 2 * n, n);
                                   const size_t row = (i >> 8) & 65535, col = i & 255; v += __uint_as_float((unsigned)((const bf16*)(ws + WS_ASSM))[row * 384 + col] << 16); }
            if (DUMP_LEVEL >= 2) { v += B(WS_YATT, (size_t)TOK * 512);
                                   const size_t row = (i >> 7) & 65535, col = 256 + (i & 127); v += __uint_as_float((unsigned)((const bf16*)(ws + WS_ASSM))[row * 384 + col] << 16); }
            if (DUMP_LEVEL == 3) { v += B(WS_YG, (size_t)TOK * 512) + B(WS_R1, n); }
            args.out[i] = v;
        }
    }
#endif
#undef IN
#undef SEAM
}

#ifndef MK_N_LAUNCHES
#define MK_N_LAUNCHES 1
#endif
#ifndef RUN_MASK
#define RUN_MASK 0x3fff
#endif
extern "C" void kernel_launch(void* const* d_in, const int* in_sizes, int n_in, void* d_out, int out_size, void* d_ws, size_t ws_size, hipStream_t stream) {
    static int grid = 0;
    if (grid == 0) {
        if (n_in != 34 || in_sizes[0] != TOK * DM || out_size != TOK * DM || ws_size < WS_END) {
            fprintf(stderr, "kernel_launch: unexpected shapes (n_in %d, in0 %d, out %d, ws %zu); nothing launched\n", n_in, n_in > 0 ? in_sizes[0] : -1, out_size, ws_size); grid = -1; return; }
        int dev = 0, cus = 0, per_cu = 0;
        if (hipGetDevice(&dev) != hipSuccess || hipDeviceGetAttribute(&cus, hipDeviceAttributeMultiprocessorCount, dev) != hipSuccess) { grid = -1; return; }
        if (hipFuncSetAttribute((const void*)fwd_kernel, hipFuncAttributeMaxDynamicSharedMemorySize, LDS_BYTES) != hipSuccess) { fprintf(stderr, "kernel_launch: hipFuncSetAttribute failed\n"); grid = -1; return; }
        if (hipOccupancyMaxActiveBlocksPerMultiprocessor(&per_cu, (const void*)fwd_kernel, NWAVES * 64, LDS_BYTES) != hipSuccess || per_cu < 1) {
            fprintf(stderr, "kernel_launch: occupancy query reports %d workgroups per CU\n", per_cu); per_cu = 1; }
        (void)hipGetLastError();
        grid = cus;
        if (grid > 256) grid = 256;
        if (grid % 8 != 0) grid -= grid % 8;
    }
    if (grid <= 0) return;
    if (hipMemsetAsync((char*)d_ws + WS_CTL, 0, CTL_ZERO_BYTES, stream) != hipSuccess) return;
    Args a{};
    for (int i = 0; i < 34; ++i) a.in[i] = (const float*)d_in[i];
    a.out = (float*)d_out; a.ws = (unsigned char*)d_ws;
    if (MK_N_LAUNCHES == 1) {
        a.ph_lo = 0; a.ph_hi = NPHASE;
        hipLaunchKernelGGL(fwd_kernel, dim3(grid), dim3(NWAVES * 64), LDS_BYTES, stream, a);
    } else {
        for (int k = 0; k < NPHASE + 1; ++k) { if (!((RUN_MASK >> k) & 1)) continue; a.ph_lo = k; a.ph_hi = k + 1; hipLaunchKernelGGL(fwd_kernel, dim3(grid), dim3(NWAVES * 64), LDS_BYTES, stream, a); }
    }
}
```

```cpp
#include <hip/hip_runtime.h>
#include <cstdio>
#include <cstdint>
namespace pg8 {
#define PG8_LAS __attribute__((address_space(3)))
typedef unsigned short bf16_t;
typedef short bf16x8 __attribute__((ext_vector_type(8)));
typedef float f32x4 __attribute__((ext_vector_type(4)));
typedef unsigned u32x4 __attribute__((ext_vector_type(4)));
constexpr int BM = 256, BK = 64, HALF = 128, HTB = HALF * BK * 2  , STAGE_BYTES = 8 * HTB, NXCD = 8, WGM = 8;

__host__ __device__ __forceinline__ int lds_byte(int r, int c) { const int st = (r >> 4) * 2 + (c >> 5), rr = r & 15, cc = c & 31, ob = rr * 64 + cc * 2; return st * 1024 + (ob ^ (((ob >> 9) & 1) << 5)); }
__host__ __device__ __forceinline__ void stage_rc(int b, int& R, int& C) { const int st = b / 1024, sb = b % 1024, swz = sb ^ (((sb >> 9) & 1) << 5); R = (st >> 1) * 16 + swz / 64; C = (st & 1) * 32 + (swz % 64) / 2; }
__host__ __device__ __forceinline__ int perm32(int rho) { const int n = rho >> 4, i = rho & 15; return 8 * (i >> 2) + 4 * n + (i & 3); }

struct Unit { int pm, pn; };
struct Gemm { const bf16_t* A; const bf16_t* Bt; int M, N, K; };

struct StaticOrder {
    int nM, nN, nwg, G, c;
    __host__ __device__ void init(int M, int N, int G_, int c_) { nM = M / BM; nN = N / BM; nwg = nM * nN; G = G_; c = c_; }
    __host__ __device__ bool next(int i, Unit& u) const {
        const long L = (long)i * G + c; if (L >= nwg) return false;
        int wgid = (int)L; { const int q = nwg / NXCD, r = nwg % NXCD, xcd = wgid % NXCD, off = wgid / NXCD; wgid = (xcd < r ? xcd * (q + 1) : r * (q + 1) + (xcd - r) * q) + off; }
        const int nig = WGM * nN, gid = wgid / nig, fm = gid * WGM, gsz = (nM - fm) < WGM ? (nM - fm) : WGM;
        u.pm = fm + ((wgid % nig) % gsz); u.pn = (wgid % nig) / gsz; return true;
    }
    __device__ __forceinline__ void a_ready(const Unit&) const {}
    __device__ __forceinline__ void done(const Unit&) const {}
};

__device__ __forceinline__ unsigned cvt_pk_bf16(float lo, float hi) { unsigned r; asm volatile("v_cvt_pk_bf16_f32 %0, %1, %2" : "=v"(r) : "v"(lo), "v"(hi)); return r; }
typedef float f32x2 __attribute__((ext_vector_type(2)));
template <class Epi, class Sched, bool ALIGN_EPI = false, bool SP2 = false>
__device__ __forceinline__ void gemm_phase(PG8_LAS unsigned char* lds, const Gemm g, const Sched& S, const Epi& E) {
    int tid_o = threadIdx.x; asm volatile("" : "+v"(tid_o));
    const int tid = tid_o, wid = __builtin_amdgcn_readfirstlane(tid >> 6), lane = tid & 63, wr = wid >> 2, wc = wid & 3, fr = lane & 15, fq = lane >> 4;
    const int K = g.K, nt = K / BK;
    unsigned voffA[2], voffB[2];
#pragma unroll
    for (int i = 0; i < 2; ++i) { int R, C; stage_rc(tid * 16 + i * 8192, R, C); const int Rb = Epi::PERM ? ((R & ~31) + perm32(R & 31)) : R;
        voffA[i] = (unsigned)(R * K + C) * 2u; voffB[i] = (unsigned)(Rb * K + C) * 2u; }
    const size_t kstep = (size_t)(BK * 2);
    const size_t hstep = (size_t)HALF * K * 2;
    const size_t tstep = 2 * hstep;
    const unsigned ldsw = (unsigned)wid * 1024u;
    const int aoff = lds_byte(wr * 64 + fr, fq * 8), boff = lds_byte(wc * 32 + fr, fq * 8);
#define PG8_SA(b, h) (((b) * 2 + (h)) * HTB)
#define PG8_SB(b, h) ((4 + (b) * 2 + (h)) * HTB)
#define PG8_STAGE(bufoff, gbase, voff) do { _Pragma("unroll") for (int _i = 0; _i < 2; ++_i) \
        __builtin_amdgcn_global_load_lds((const unsigned*)((const char*)(gbase) + (voff)[_i]), (PG8_LAS unsigned*)(lds + (bufoff) + ldsw + _i * 8192), 16, 0, 0); } while (0)
#define PG8_LDA(dst, b, h) do { _Pragma("unroll") for (int m = 0; m < 4; ++m) _Pragma("unroll") for (int k = 0; k < 2; ++k) dst[m][k] = *(const PG8_LAS bf16x8*)(lds + PG8_SA(b, h) + aoff + m * 2048 + k * 1024); } while (0)
#define PG8_LDB(dst, b, h) do { _Pragma("unroll") for (int n = 0; n < 2; ++n) _Pragma("unroll") for (int k = 0; k < 2; ++k) dst[n][k] = *(const PG8_LAS bf16x8*)(lds + PG8_SB(b, h) + boff + n * 2048 + k * 1024); } while (0)
#define PG8_MMA(ai, bj, At, Bt) do { __builtin_amdgcn_s_setprio(1); _Pragma("unroll") for (int m = 0; m < 4; ++m) _Pragma("unroll") for (int n = 0; n < 2; ++n) _Pragma("unroll") for (int k = 0; k < 2; ++k) \
        acc[ai][bj][m][n] = __builtin_amdgcn_mfma_f32_16x16x32_bf16(Bt[n][k], At[m][k], acc[ai][bj][m][n], 0, 0, 0); __builtin_amdgcn_s_setprio(0); } while (0)
#define PG8_WAIT_V(n) asm volatile("s_waitcnt vmcnt(" #n ")" ::: "memory")
#define PG8_WAIT_L(n) asm volatile("s_waitcnt lgkmcnt(" #n ")" ::: "memory")
#define PG8_BAR __builtin_amdgcn_s_barrier()
#define PG8_SCHED __builtin_amdgcn_sched_barrier(0)
    Unit cur, nxt; int ui = 0;
    if (!S.next(0, cur)) return;
    f32x4 acc[2][2][4][2];
#pragma unroll
    for (int a = 0; a < 2; ++a)
#pragma unroll
        for (int b = 0; b < 2; ++b)
#pragma unroll
            for (int m = 0; m < 4; ++m)
#pragma unroll
                for (int n = 0; n < 2; ++n) acc[a][b][m][n] = (f32x4){0.f, 0.f, 0.f, 0.f};
    bf16x8 At[4][2], B0[2][2], B1[2][2];
    const char* cA = (const char*)g.A + (size_t)cur.pm * tstep; const char* cB = (const char*)g.Bt + (size_t)cur.pn * tstep;
    S.a_ready(cur);
    if constexpr (SP2) {
        PG8_STAGE(PG8_SB(0, 0), cB, voffB); PG8_STAGE(PG8_SB(0, 1), cB + hstep, voffB); PG8_STAGE(PG8_SA(0, 0), cA, voffA); PG8_STAGE(PG8_SA(0, 1), cA + hstep, voffA);
        if (wr == 1) PG8_BAR;
        PG8_WAIT_V(2); PG8_BAR;
        PG8_STAGE(PG8_SB(1, 0), cB + kstep, voffB); PG8_STAGE(PG8_SA(1, 0), cA + kstep, voffA); PG8_STAGE(PG8_SB(1, 1), cB + hstep + kstep, voffB);
        PG8_WAIT_V(6); PG8_BAR;
    } else {
        PG8_STAGE(PG8_SB(0, 0), cB, voffB); PG8_STAGE(PG8_SA(0, 0), cA, voffA); PG8_STAGE(PG8_SB(0, 1), cB + hstep, voffB); PG8_STAGE(PG8_SA(0, 1), cA + hstep, voffA);
        if (wr == 1) PG8_BAR;
        PG8_WAIT_V(4); PG8_BAR;
        PG8_STAGE(PG8_SB(1, 0), cB + kstep, voffB); PG8_STAGE(PG8_SA(1, 0), cA + kstep, voffA); PG8_STAGE(PG8_SB(1, 1), cB + hstep + kstep, voffB);
        PG8_WAIT_V(6); PG8_BAR;
    }
    for (;;) {
        const bool has_next = S.next(ui + 1, nxt);
        const char* nA = has_next ? (const char*)g.A + (size_t)nxt.pm * tstep : cA; const char* nB = has_next ? (const char*)g.Bt + (size_t)nxt.pn * tstep : cB;
#pragma nounroll
        for (int t = 0; t < nt; t += 2) {
            const bool last = (t == nt - 2);
            const char* a1 = cA + (size_t)(t + 1) * kstep;
            const char* a2 = last ? nA : cA + (size_t)(t + 2) * kstep; const char* b2 = last ? nB : cB + (size_t)(t + 2) * kstep;
            const char* a3 = a2 + kstep; const char* b3 = b2 + kstep;
            if (last && has_next) S.a_ready(nxt);
            if constexpr (SP2) {
            PG8_LDB(B0, 0, 0); PG8_LDB(B1, 0, 1); PG8_SCHED; PG8_LDA(At, 0, 0); PG8_STAGE(PG8_SA(1, 1), a1 + hstep, voffA);
            PG8_WAIT_V(8); PG8_WAIT_L(0); PG8_BAR; PG8_MMA(0, 0, At, B0); PG8_MMA(0, 1, At, B1); PG8_BAR; PG8_SCHED;
            PG8_LDA(At, 0, 1); PG8_STAGE(PG8_SB(0, 0), b2, voffB); PG8_STAGE(PG8_SB(0, 1), b2 + hstep, voffB); PG8_STAGE(PG8_SA(0, 0), a2, voffA);
            PG8_WAIT_V(8); PG8_WAIT_L(0); PG8_BAR; PG8_MMA(1, 0, At, B0); PG8_MMA(1, 1, At, B1); PG8_BAR; PG8_SCHED;
            PG8_LDB(B0, 1, 0); PG8_LDB(B1, 1, 1); PG8_SCHED; PG8_LDA(At, 1, 0); PG8_STAGE(PG8_SA(0, 1), a2 + hstep, voffA);
            PG8_WAIT_V(8); PG8_WAIT_L(0); PG8_BAR; PG8_MMA(0, 0, At, B0); PG8_MMA(0, 1, At, B1); PG8_BAR; PG8_SCHED;
            PG8_LDA(At, 1, 1); PG8_STAGE(PG8_SB(1, 0), b3, voffB); PG8_STAGE(PG8_SB(1, 1), b3 + hstep, voffB); PG8_STAGE(PG8_SA(1, 0), a3, voffA);
            PG8_WAIT_V(8); PG8_WAIT_L(0); PG8_BAR; PG8_MMA(1, 0, At, B0); PG8_MMA(1, 1, At, B1); PG8_BAR; PG8_SCHED;
            } else {
            PG8_LDB(B0, 0, 0); PG8_SCHED; PG8_LDA(At, 0, 0); PG8_STAGE(PG8_SA(1, 1), a1 + hstep, voffA);
            PG8_WAIT_L(8); PG8_BAR; PG8_WAIT_L(0); PG8_MMA(0, 0, At, B0); PG8_BAR; PG8_SCHED;
            PG8_LDB(B1, 0, 1); PG8_STAGE(PG8_SB(0, 0), b2, voffB);
            PG8_BAR; PG8_WAIT_L(0); PG8_MMA(0, 1, At, B1); PG8_BAR;
            PG8_LDA(At, 0, 1); PG8_STAGE(PG8_SA(0, 0), a2, voffA);
            PG8_BAR; PG8_WAIT_L(0); PG8_MMA(1, 0, At, B0); PG8_BAR; PG8_SCHED;
            PG8_STAGE(PG8_SB(0, 1), b2 + hstep, voffB);
            PG8_WAIT_V(6); PG8_BAR; PG8_MMA(1, 1, At, B1); PG8_BAR;
            PG8_LDB(B0, 1, 0); PG8_SCHED; PG8_LDA(At, 1, 0); PG8_STAGE(PG8_SA(0, 1), a2 + hstep, voffA);
            PG8_WAIT_L(8); PG8_BAR; PG8_WAIT_L(0); PG8_MMA(0, 0, At, B0); PG8_BAR; PG8_SCHED;
            PG8_LDB(B1, 1, 1); PG8_STAGE(PG8_SB(1, 0), b3, voffB);
            PG8_BAR; PG8_WAIT_L(0); PG8_MMA(0, 1, At, B1); PG8_BAR;
            PG8_LDA(At, 1, 1); PG8_STAGE(PG8_SA(1, 0), a3, voffA);
            PG8_BAR; PG8_WAIT_L(0); PG8_MMA(1, 0, At, B0); PG8_BAR; PG8_SCHED;
            PG8_STAGE(PG8_SB(1, 1), b3 + hstep, voffB);
            PG8_WAIT_V(6); PG8_BAR; PG8_MMA(1, 1, At, B1); PG8_BAR;
            }
        }
        if constexpr (ALIGN_EPI) { if (wr == 0) PG8_BAR; }
        if constexpr (!Epi::AFTER_DRAIN) { int lane_e = lane; asm volatile("" : "+v"(lane_e)); E(acc, cur, wr, wc, lane_e & 15, lane_e >> 4); S.done(cur); }
        if (!has_next) break;
#pragma unroll
        for (int a = 0; a < 2; ++a)
#pragma unroll
            for (int b = 0; b < 2; ++b)
#pragma unroll
                for (int m = 0; m < 4; ++m)
#pragma unroll
                    for (int n = 0; n < 2; ++n) acc[a][b][m][n] = (f32x4){0.f, 0.f, 0.f, 0.f};
        cur = nxt; cA = nA; cB = nB; ++ui;
        if constexpr (ALIGN_EPI) { if (wr == 1) PG8_BAR; }
    }
    PG8_WAIT_V(0);
    if constexpr (!ALIGN_EPI) { if (wr == 0) PG8_BAR; }
    PG8_BAR;
    if constexpr (Epi::AFTER_DRAIN) { int lane_e = lane; asm volatile("" : "+v"(lane_e)); E.fused(acc, cur, wr, wc, lane_e & 15, lane_e >> 4, lds, wid, lane_e); S.done(cur); }
#undef PG8_SA
#undef PG8_SB
#undef PG8_STAGE
#undef PG8_LDA
#undef PG8_LDB
#undef PG8_MMA
#undef PG8_WAIT_V
#undef PG8_WAIT_L
#undef PG8_BAR
#undef PG8_SCHED
}
}

typedef unsigned short bf16;
typedef pg8::f32x4 f32x4;
typedef pg8::u32x4 u32x4;
typedef pg8::bf16x8 bf16x8;
typedef unsigned u32x2 __attribute__((ext_vector_type(2)));
typedef float f32x16 __attribute__((ext_vector_type(16)));
typedef short v4i16_t __attribute__((ext_vector_type(4)));
#define LAS __attribute__((address_space(3)))

constexpr int TOK = 32768, DM = 1024, SEQ = 4096;
constexpr int NSLOT = 2 * TOK, MAXROWS = NSLOT + 32 * 256, MAXBLK = MAXROWS / 256;
constexpr float LOG2E = 1.4426950408889634f;
constexpr float QSCALE = 0.125f * LOG2E;
constexpr float RMS_EPS = 1e-6f;
constexpr int NWAVES = 8;

constexpr size_t MiB = 1u << 20;
constexpr size_t WS_CTL = 0, CTL_ZERO_BYTES = 1 * MiB;
constexpr size_t WS_A16 = 1 * MiB;
constexpr size_t WS_RSS1 = 2 * MiB;
constexpr size_t WS_RSTD1 = 4 * MiB;
constexpr size_t WS_RSTD2 = 4 * MiB + 256 * 1024;
constexpr size_t WS_SLOT_E = 5 * MiB;
constexpr size_t WS_SLOT_POS = 5 * MiB + 256 * 1024;
constexpr size_t WS_SLOT_W = 5 * MiB + 512 * 1024;
constexpr size_t WS_SLOT_DEST = 5 * MiB + 768 * 1024;
constexpr size_t WS_DEST_W = 6 * MiB;
constexpr size_t WS_DEST_RSTD = 6 * MiB + 512 * 1024;
constexpr size_t WS_WCAT = 9 * MiB;
constexpr size_t WS_WGLU = WS_WCAT + 6656 * 1024;
constexpr size_t WS_WR = 16 * MiB;
constexpr size_t WS_WPLE = 16 * MiB + 512 * 1024;
constexpr size_t WS_WA = 17 * MiB, WS_WB = 18 * MiB, WS_WOUT = 19 * MiB, WS_WPG = 21 * MiB;
constexpr size_t WS_M1T = 23 * MiB;
constexpr size_t WS_BSSM = 25 * MiB;
constexpr size_t WS_WGU = 32 * MiB;
constexpr size_t WS_WD = 96 * MiB;
constexpr size_t WS_R1 = 128 * MiB;
constexpr size_t WS_ASSM = 192 * MiB;
constexpr size_t WS_QKV = 240 * MiB;
constexpr size_t WS_MERGED = 192 * MiB;
constexpr size_t WS_GATES = 288 * MiB;
constexpr size_t WS_YATT = 416 * MiB;
constexpr size_t WS_YG = 448 * MiB;
constexpr size_t WS_PB = 480 * MiB;
constexpr size_t WS_XD = 192 * MiB;
constexpr size_t WS_ACT = 336 * MiB;
constexpr size_t WS_PP = 408 * MiB;
constexpr size_t WS_END = 496 * MiB;
constexpr int CW_BAR = 4096;
constexpr int CW_CNT = 8192;
constexpr int CW_BLK = 12288;

constexpr int RING_OFF = 0, RING_BYTES = 131072;
constexpr int LDSCTL_OFF = RING_BYTES, MISC_OFF = LDSCTL_OFF + 320;
constexpr int EXTRA_OFF = RING_BYTES + 1024;
constexpr int LDS_BYTES = 147456;

#define RLX_AGENT __ATOMIC_RELAXED, __HIP_MEMORY_SCOPE_AGENT
#define LDS_WAIT() asm volatile("s_waitcnt lgkmcnt(0)" ::: "memory")
#define VM_WAIT() asm volatile("s_waitcnt vmcnt(0)" ::: "memory")
typedef unsigned gu32;

typedef float f32x2_t __attribute__((ext_vector_type(2))); typedef __bf16 bf16x2_t __attribute__((ext_vector_type(2)));
__device__ __forceinline__ unsigned pk2(float lo, float hi) { f32x2_t v = {lo, hi}; bf16x2_t b = __builtin_convertvector(v, bf16x2_t); return __builtin_bit_cast(unsigned, b); }
__device__ __forceinline__ float bflo(unsigned w) { return __uint_as_float(w << 16); }
__device__ __forceinline__ float bfhi(unsigned w) { return __uint_as_float(w & 0xffff0000u); }
__device__ __forceinline__ float ex2(float x) { return __builtin_amdgcn_exp2f(x); }
__device__ __forceinline__ float sigm(float x) { return __builtin_amdgcn_rcpf(1.0f + ex2(-x * LOG2E)); }
__device__ __forceinline__ float gelu_tanh(float x) { const float z = 1.5957691216057308f * (x + 0.044715f * x * x * x); return x * sigm(z); }
__device__ __forceinline__ float wave_sum(float v) {
#pragma unroll
    for (int o = 1; o < 64; o <<= 1) v += __shfl_xor(v, o);
    return v;
}
__device__ __forceinline__ u32x4 pack8(const f32x4& a, const f32x4& b) { u32x4 w; w.x = pk2(a[0], a[1]); w.y = pk2(a[2], a[3]); w.z = pk2(b[0], b[1]); w.w = pk2(b[2], b[3]); return w; }
__device__ __forceinline__ void unpack8(const u32x4& w, f32x4& a, f32x4& b) { a[0] = bflo(w.x); a[1] = bfhi(w.x); a[2] = bflo(w.y); a[3] = bfhi(w.y); b[0] = bflo(w.z); b[1] = bfhi(w.z); b[2] = bflo(w.w); b[3] = bfhi(w.w); }

struct OneUnit {
    int pm, pn; bool have;
    __device__ __forceinline__ bool next(int i, pg8::Unit& u) const { if (i > 0 || !have) return false; u.pm = pm; u.pn = pn; return true; }
    __device__ __forceinline__ void a_ready(const pg8::Unit&) const {}
    __device__ __forceinline__ void done(const pg8::Unit&) const {}
};
struct MoeOrder {
    int total, G, c; const LAS int* blk;
    __device__ __forceinline__ bool next(int i, pg8::Unit& u) const {
        const int L = i * G + c; if (L >= total) return false;
        const int rb = L >> 2; u.pm = rb; u.pn = __builtin_amdgcn_readfirstlane(blk[1 + rb]) * 4 + (L & 3); return true; }
    __device__ __forceinline__ void a_ready(const pg8::Unit&) const {}
    __device__ __forceinline__ void done(const pg8::Unit&) const {}
};

typedef const f32x4 (&AccRef)[2][2][4][2];

struct Epi1 {
    static constexpr bool PERM = true, AFTER_DRAIN = false;
    bf16* Assm; bf16* qkv; bf16* gates; const float* bgate;
    __device__ __forceinline__ void operator()(AccRef acc, const pg8::Unit& u, int wr, int wc, int fr, int fq) const {
        const int pn = u.pn, row0 = u.pm * 256 + wr * 64 + fr, cl0 = wc * 32 + 8 * fq;
        if (pn < 2) {
#pragma unroll
            for (int ai = 0; ai < 2; ++ai)
#pragma unroll
                for (int m = 0; m < 4; ++m) { const int r = row0 + ai * 128 + m * 16, chunk = r >> 4, s = r & 15;
#pragma unroll
                    for (int bj = 0; bj < 2; ++bj) { const int col = pn * 256 + bj * 128 + cl0, g = col >> 4, c = col & 15;
                        *(u32x4*)(Assm + ((size_t)(g * 2048 + chunk) * 384 + s * 16 + c)) = pack8(acc[ai][bj][m][0], acc[ai][bj][m][1]); } }
        } else if (pn < 5) {
            const float sc = (pn < 4) ? QSCALE : 1.0f;
#pragma unroll
            for (int ai = 0; ai < 2; ++ai)
#pragma unroll
                for (int m = 0; m < 4; ++m) { const int r = row0 + ai * 128 + m * 16;
#pragma unroll
                    for (int bj = 0; bj < 2; ++bj) { const int col = pn * 256 + bj * 128 + cl0 - 512;
                        *(u32x4*)(qkv + (size_t)r * 768 + col) = pack8(acc[ai][bj][m][0] * sc, acc[ai][bj][m][1] * sc); } }
        } else {
#pragma unroll
            for (int bj = 0; bj < 2; ++bj) { const int gcol = (pn - 5) * 256 + bj * 128 + cl0;
                const f32x4 b0 = *(const f32x4*)(bgate + gcol), b1 = *(const f32x4*)(bgate + gcol + 4);
#pragma unroll
                for (int ai = 0; ai < 2; ++ai)
#pragma unroll
                    for (int m = 0; m < 4; ++m) { const int r = row0 + ai * 128 + m * 16; f32x4 v0 = acc[ai][bj][m][0] + b0, v1 = acc[ai][bj][m][1] + b1;
#pragma unroll
                        for (int i = 0; i < 4; ++i) { v0[i] = sigm(v0[i]); v1[i] = sigm(v1[i]); }
                        *(u32x4*)(gates + (size_t)r * 2048 + gcol) = pack8(v0, v1); } }
        }
    }
};
struct EpiSsm {
    static constexpr bool PERM = true, AFTER_DRAIN = false;
    bf16* yg;
    __device__ __forceinline__ void operator()(AccRef acc, const pg8::Unit& u, int wr, int wc, int fr, int fq) const {
        const int g = u.pn, row0 = u.pm * 256 + wr * 64 + fr, cl0 = wc * 32 + 8 * fq;
#pragma unroll
        for (int bj = 0; bj < 2; ++bj) { const int n = bj * 128 + cl0, s = n >> 4, c = n & 15;
#pragma unroll
            for (int ai = 0; ai < 2; ++ai)
#pragma unroll
                for (int m = 0; m < 4; ++m) { const int R = row0 + ai * 128 + m * 16, chunk = R & 2047;
                    f32x4 v0 = acc[ai][bj][m][0], v1 = acc[ai][bj][m][1];
#pragma unroll
                    for (int i = 0; i < 4; ++i) { v0[i] = gelu_tanh(v0[i]); v1[i] = gelu_tanh(v1[i]); }
                    *(u32x4*)(yg + (size_t)(chunk * 16 + s) * 512 + g * 16 + c) = pack8(v0, v1); } }
    }
};
struct EpiGlu {
    static constexpr bool PERM = true, AFTER_DRAIN = false;
    const bf16* yg; bf16* yssm; const float* bglu;
    __device__ __forceinline__ void operator()(AccRef acc, const pg8::Unit& u, int wr, int wc, int fr, int fq) const {
        const int row0 = u.pm * 256 + wr * 64 + fr, cl0 = u.pn * 256 + wc * 32 + 8 * fq;
#pragma unroll
        for (int bj = 0; bj < 2; ++bj) { const int col = bj * 128 + cl0;
            const f32x4 b0 = *(const f32x4*)(bglu + col), b1 = *(const f32x4*)(bglu + col + 4);
#pragma unroll
            for (int ai = 0; ai < 2; ++ai)
#pragma unroll
                for (int m = 0; m < 4; ++m) { const int r = row0 + ai * 128 + m * 16;
                    const u32x4 yw = *(const u32x4*)(yg + (size_t)r * 512 + col); f32x4 y0, y1; unpack8(yw, y0, y1);
                    f32x4 v0 = acc[ai][bj][m][0] + b0, v1 = acc[ai][bj][m][1] + b1;
#pragma unroll
                    for (int i = 0; i < 4; ++i) { v0[i] = y0[i] * sigm(v0[i]); v1[i] = y1[i] * sigm(v1[i]); }
                    *(u32x4*)(yssm + (size_t)r * 512 + col) = pack8(v0, v1); } }
    }
};
template <bool ADD> struct EpiBranch {
    static constexpr bool PERM = true, AFTER_DRAIN = false;
    const bf16* gates; int goff; const bf16* addend; bf16* out;
    __device__ __forceinline__ void operator()(AccRef acc, const pg8::Unit& u, int wr, int wc, int fr, int fq) const {
        const int row0 = u.pm * 256 + wr * 64 + fr, cl0 = u.pn * 256 + wc * 32 + 8 * fq;
#pragma unroll
        for (int ai = 0; ai < 2; ++ai)
#pragma unroll
            for (int m = 0; m < 4; ++m) { const int r = row0 + ai * 128 + m * 16;
#pragma unroll
                for (int bj = 0; bj < 2; ++bj) { const int col = bj * 128 + cl0;
                    const u32x4 gw = *(const u32x4*)(gates + (size_t)r * 2048 + goff + col); f32x4 g0, g1; unpack8(gw, g0, g1);
                    f32x4 v0 = g0 * acc[ai][bj][m][0], v1 = g1 * acc[ai][bj][m][1];
                    if (ADD) { const u32x4 aw = *(const u32x4*)(addend + (size_t)r * 1024 + col); f32x4 a0, a1; unpack8(aw, a0, a1); v0 += a0; v1 += a1; }
                    *(u32x4*)(out + (size_t)r * 1024 + col) = pack8(v0, v1); } }
    }
};
struct EpiPlain {
    static constexpr bool PERM = true, AFTER_DRAIN = false;
    bf16* out; int ldc;
    __device__ __forceinline__ void operator()(AccRef acc, const pg8::Unit& u, int wr, int wc, int fr, int fq) const {
        const int row0 = u.pm * 256 + wr * 64 + fr, cl0 = u.pn * 256 + wc * 32 + 8 * fq;
#pragma unroll
        for (int ai = 0; ai < 2; ++ai)
#pragma unroll
            for (int m = 0; m < 4; ++m) { const int r = row0 + ai * 128 + m * 16;
#pragma unroll
                for (int bj = 0; bj < 2; ++bj) *(u32x4*)(out + (size_t)r * ldc + bj * 128 + cl0) = pack8(acc[ai][bj][m][0], acc[ai][bj][m][1]); }
    }
};
struct EpiWout {
    static constexpr bool PERM = false, AFTER_DRAIN = false;
    const float* x; bf16* xg; const float* gain; float* rss;
    __device__ __forceinline__ void operator()(AccRef acc, const pg8::Unit& u, int wr, int wc, int fr, int fq) const {
        const int row0 = u.pm * 256 + wr * 64 + fr, col0 = u.pn * 256 + wc * 32 + 4 * fq;
        f32x4 gv[2][2];
#pragma unroll
        for (int bj = 0; bj < 2; ++bj)
#pragma unroll
            for (int n = 0; n < 2; ++n) gv[bj][n] = *(const f32x4*)(gain + col0 + bj * 128 + n * 16);
#pragma unroll
        for (int ai = 0; ai < 2; ++ai)
#pragma unroll
            for (int m = 0; m < 4; ++m) { const int r = row0 + ai * 128 + m * 16; const size_t off = (size_t)r * 1024 + col0; float ss = 0.f;
#pragma unroll
                for (int bj = 0; bj < 2; ++bj)
#pragma unroll
                    for (int n = 0; n < 2; ++n) { const f32x4 xv = *(const f32x4*)(x + off + bj * 128 + n * 16); const f32x4 v = xv + acc[ai][bj][m][n];
                        ss += (v[0] * v[0] + v[1] * v[1]) + (v[2] * v[2] + v[3] * v[3]);
                        const f32x4 w = v * gv[bj][n]; u32x2 o; o.x = pk2(w[0], w[1]); o.y = pk2(w[2], w[3]); *(u32x2*)(xg + off + bj * 128 + n * 16) = o; }
                ss += __shfl_xor(ss, 16); ss += __shfl_xor(ss, 32);
                if (fq == 0) rss[(size_t)r * 16 + u.pn * 4 + wc] = ss; }
    }
};
struct EpiPle {
    static constexpr bool PERM = false, AFTER_DRAIN = false;
    const bf16* x2g; const float* gain; const bf16* pp; const float* rstd; const float* bias; bf16* x3h; float* rss;
    __device__ __forceinline__ void operator()(AccRef acc, const pg8::Unit& u, int wr, int wc, int fr, int fq) const {
        const int row0 = u.pm * 256 + wr * 64 + fr, col0 = u.pn * 256 + wc * 32 + 4 * fq;
        f32x4 bv[2][2], ig[2][2];
#pragma unroll
        for (int bj = 0; bj < 2; ++bj)
#pragma unroll
            for (int n = 0; n < 2; ++n) { bv[bj][n] = *(const f32x4*)(bias + col0 + bj * 128 + n * 16); const f32x4 gq = *(const f32x4*)(gain + col0 + bj * 128 + n * 16);
#pragma unroll
                for (int i = 0; i < 4; ++i) ig[bj][n][i] = 1.0f / gq[i]; }
#pragma unroll
        for (int ai = 0; ai < 2; ++ai)
#pragma unroll
            for (int m = 0; m < 4; ++m) { const int r = row0 + ai * 128 + m * 16; const size_t off = (size_t)r * 1024 + col0; const float rs = rstd[r]; float ss = 0.f;
#pragma unroll
                for (int bj = 0; bj < 2; ++bj)
#pragma unroll
                    for (int n = 0; n < 2; ++n) { const size_t o = off + bj * 128 + n * 16; const u32x2 xw = *(const u32x2*)(x2g + o); const u32x2 pw = *(const u32x2*)(pp + o);
                        f32x4 v = acc[ai][bj][m][n] * rs + bv[bj][n];
                        v[0] = bflo(xw.x) * ig[bj][n][0] + bflo(pw.x) * sigm(v[0]); v[1] = bfhi(xw.x) * ig[bj][n][1] + bfhi(pw.x) * sigm(v[1]);
                        v[2] = bflo(xw.y) * ig[bj][n][2] + bflo(pw.y) * sigm(v[2]); v[3] = bfhi(xw.y) * ig[bj][n][3] + bfhi(pw.y) * sigm(v[3]);
                        ss += (v[0] * v[0] + v[1] * v[1]) + (v[2] * v[2] + v[3] * v[3]);
                        u32x2 ow; ow.x = pk2(v[0], v[1]); ow.y = pk2(v[2], v[3]); *(u32x2*)(x3h + o) = ow; }
                ss += __shfl_xor(ss, 16); ss += __shfl_xor(ss, 32);
                if (fq == 0) rss[(size_t)r * 16 + u.pn * 4 + wc] = ss; }
    }
};
struct EpiMoe1 {
    static constexpr bool PERM = true, AFTER_DRAIN = false;
    bf16* act; const float* drstd;
    __device__ __forceinline__ void operator()(AccRef acc, const pg8::Unit& u, int wr, int wc, int fr, int fq) const {
        const int row0 = u.pm * 256 + wr * 64 + fr, col0 = (u.pn & 3) * 128 + wc * 32 + 8 * fq;
#pragma unroll
        for (int ai = 0; ai < 2; ++ai)
#pragma unroll
            for (int m = 0; m < 4; ++m) { const int r = row0 + ai * 128 + m * 16; const float rs = drstd[r]; f32x4 o[2];
#pragma unroll
                for (int n = 0; n < 2; ++n)
#pragma unroll
                    for (int i = 0; i < 4; ++i) { const float gq = acc[ai][0][m][n][i] * rs, uq = acc[ai][1][m][n][i] * rs; o[n][i] = gq * sigm(gq) * uq; }
                *(u32x4*)(act + (size_t)r * 512 + col0) = pack8(o[0], o[1]); }
    }
};
struct EpiMoe2 {
    static constexpr bool PERM = true, AFTER_DRAIN = false;
    bf16* yd; const float* dw;
    __device__ __forceinline__ void operator()(AccRef acc, const pg8::Unit& u, int wr, int wc, int fr, int fq) const {
        const int row0 = u.pm * 256 + wr * 64 + fr, cl0 = (u.pn & 3) * 256 + wc * 32 + 8 * fq;
#pragma unroll
        for (int ai = 0; ai < 2; ++ai)
#pragma unroll
            for (int m = 0; m < 4; ++m) { const int r = row0 + ai * 128 + m * 16; const float w = dw[r];
#pragma unroll
                for (int bj = 0; bj < 2; ++bj) *(u32x4*)(yd + (size_t)r * 1024 + bj * 128 + cl0) = pack8(acc[ai][bj][m][0] * w, acc[ai][bj][m][1] * w); }
    }
};
struct EpiRouter {
    static constexpr bool PERM = false, AFTER_DRAIN = true;
    const float* rss; float* rstd1; const float* brg; const float* bre; unsigned* cnt; int* slot_e; int* slot_pos; float* slot_w;
    __device__ __forceinline__ void fused(f32x4 (&acc)[2][2][4][2], const pg8::Unit& u, int wr, int wc, int fr, int fq, PG8_LAS unsigned char* lds, int wid, int lane) const {
        PG8_LAS float* lg = (PG8_LAS float*)lds;
        PG8_LAS int* lh = (PG8_LAS int*)(lds + 40960);
        int tid_q = wid * 64 + lane; asm volatile("" : "+v"(tid_q)); const int tid = tid_q;
        if (tid < 32) lh[tid] = 0;
#pragma unroll
        for (int ai = 0; ai < 2; ++ai)
#pragma unroll
            for (int m = 0; m < 4; ++m) { const int rl = ai * 128 + wr * 64 + m * 16 + fr;
                if (wc == 0) { *(PG8_LAS f32x4*)(lg + rl * 40 + 4 * fq) = acc[ai][0][m][0]; *(PG8_LAS f32x4*)(lg + rl * 40 + 16 + 4 * fq) = acc[ai][0][m][1]; }
                if (wc == 1 && fq == 0) *(PG8_LAS f32x4*)(lg + rl * 40 + 32) = acc[ai][0][m][0]; }
        asm volatile("s_waitcnt lgkmcnt(0)" ::: "memory"); __builtin_amdgcn_s_barrier(); asm volatile("" ::: "memory");
        int e0 = 0, e1 = 0, lp0 = 0, lp1 = 0; float w0 = 0.f, w1 = 0.f; const int R = u.pm * 256 + tid;
        if (tid < 256) {
            float ss = 0.f;
#pragma unroll
            for (int j = 0; j < 16; ++j) ss += rss[(size_t)R * 16 + j];
            const float rs = __builtin_amdgcn_rsqf(ss * (1.0f / 1024.0f) + RMS_EPS);
            rstd1[R] = rs;
            float gl[4];
#pragma unroll
            for (int j = 0; j < 4; ++j) gl[j] = lg[tid * 40 + j] * rs + brg[j];
            int gi = 0; float gm = gl[0];
#pragma unroll
            for (int j = 1; j < 4; ++j) if (gl[j] > gm) { gm = gl[j]; gi = j; }
            float gs = 0.f;
#pragma unroll
            for (int j = 0; j < 4; ++j) gs += ex2((gl[j] - gm) * LOG2E);
            const float gp = 1.0f / gs;
            float el[8];
#pragma unroll
            for (int j = 0; j < 8; ++j) el[j] = lg[tid * 40 + 4 + gi * 8 + j] * rs + bre[gi * 8 + j];
            int i0 = 0; float m0 = el[0];
#pragma unroll
            for (int j = 1; j < 8; ++j) if (el[j] > m0) { m0 = el[j]; i0 = j; }
            int i1 = -1; float m1 = -INFINITY;
#pragma unroll
            for (int j = 0; j < 8; ++j) if (j != i0 && el[j] > m1) { m1 = el[j]; i1 = j; }
            const float t = ex2((m1 - m0) * LOG2E);
            w0 = gp / (1.0f + t); w1 = gp * t / (1.0f + t);
            e0 = gi * 8 + i0; e1 = gi * 8 + i1;
            lp0 = __hip_atomic_fetch_add(lh + e0, 1, __ATOMIC_RELAXED, __HIP_MEMORY_SCOPE_WORKGROUP);
            lp1 = __hip_atomic_fetch_add(lh + e1, 1, __ATOMIC_RELAXED, __HIP_MEMORY_SCOPE_WORKGROUP);
        }
        asm volatile("s_waitcnt lgkmcnt(0)" ::: "memory"); __builtin_amdgcn_s_barrier(); asm volatile("" ::: "memory");
        if (tid < 32) { const int c = lh[tid]; lh[32 + tid] = (int)__hip_atomic_fetch_add(cnt + tid, (unsigned)c, __ATOMIC_RELAXED, __HIP_MEMORY_SCOPE_AGENT); }
        asm volatile("s_waitcnt vmcnt(0) lgkmcnt(0)" ::: "memory"); __builtin_amdgcn_s_barrier(); asm volatile("" ::: "memory");
        if (tid < 256) {
            slot_e[2 * R] = e0; slot_e[2 * R + 1] = e1; slot_pos[2 * R] = lh[32 + e0] + lp0; slot_pos[2 * R + 1] = lh[32 + e1] + lp1;
            slot_w[2 * R] = w0; slot_w[2 * R + 1] = w1;
        }
    }
};
#define XB_TMO      128
#define XB_XCNT(j)  (256  + 64 * (j))
#define XB_XSUB(j)  (1280 + 64 * (j))
#define XB_XGEN(j)  (2304 + 64 * (j))
#define XB_TOP      3328
#define XB_TOPGEN   3392
#define XCD_BAR_WORDS 3456
#define XB_SPIN_CAP (1u << 18)

__device__ __forceinline__ unsigned xb_ld(unsigned* p)              { return __hip_atomic_load(p, __ATOMIC_RELAXED, __HIP_MEMORY_SCOPE_AGENT); }
__device__ __forceinline__ unsigned xb_add(unsigned* p, unsigned v) { return __hip_atomic_fetch_add(p, v, __ATOMIC_RELAXED, __HIP_MEMORY_SCOPE_AGENT); }
__device__ __forceinline__ unsigned xb_xcc_id() { return (unsigned)__builtin_amdgcn_s_getreg((3 << 11) | 20) & 0xFu; }
#define XB_SPIN(cond, bar) do { unsigned _sp = 0; while (cond) { __builtin_amdgcn_s_sleep(1); \
    if ((++_sp & 255u) == 0u) { if (xb_ld(&(bar)[XB_TMO])) break; if (_sp > XB_SPIN_CAP) { atomicAdd(&(bar)[XB_TMO], 1u); break; } } } } while (0)

struct XcdBarrier {
    unsigned* bar; unsigned x;
    volatile LAS unsigned* st;
};

__device__ __forceinline__ XcdBarrier xcd_barrier_post(unsigned* bar, volatile LAS unsigned* st) {
    XcdBarrier b; b.bar = bar; b.x = xb_xcc_id(); b.st = st;
    if (threadIdx.x == 0) (void)xb_add(&bar[XB_XCNT(b.x)], 1u);
    return b;
}
__device__ __forceinline__ void xcd_barrier_complete(unsigned* bar, unsigned x, unsigned& nloc, unsigned& nx) {
    const unsigned G = gridDim.x * gridDim.y * gridDim.z;
    unsigned sum, cnt, mine, sp = 0u;
    for (;;) {
        sum = 0u; cnt = 0u; mine = 0u;
#pragma unroll
        for (unsigned j = 0; j < 16; ++j) { const unsigned c = xb_ld(&bar[XB_XCNT(j)]); sum += c; cnt += (c > 0u) ? 1u : 0u; mine = (j == x) ? c : mine; }
        if (sum == G) break;
        __builtin_amdgcn_s_sleep(1);
        if ((++sp & 255u) == 0u) { if (xb_ld(&bar[XB_TMO])) break; if (sp > XB_SPIN_CAP) { atomicAdd(&bar[XB_TMO], 1u); break; } }
    }
    nloc = mine > 0u ? mine : 1u; nx = cnt > 0u ? cnt : 1u;
}

__device__ __forceinline__ void xcd_barrier(const XcdBarrier& b) {
    asm volatile("s_waitcnt vmcnt(0)" ::: "memory");
    __syncthreads();
    if (threadIdx.x == 0) {
        unsigned* bar = b.bar;
        __builtin_amdgcn_s_waitcnt(0);
        unsigned nloc = b.st[0], nx = b.st[1];
        if (nloc == 0u) { xcd_barrier_complete(bar, b.x, nloc, nx); b.st[0] = nloc; b.st[1] = nx; }
        const unsigned old = xb_add(&bar[XB_XSUB(b.x)], 1u);
        const unsigned gen = old / nloc;
        if (old + 1u == (gen + 1u) * nloc) {
            __builtin_amdgcn_fence(__ATOMIC_RELEASE, "agent");
            asm volatile("s_waitcnt vmcnt(0)" ::: "memory");
            const unsigned og = xb_add(&bar[XB_TOP], 1u);
            const unsigned tg = og / nx;
            if (og + 1u == (tg + 1u) * nx) xb_add(&bar[XB_TOPGEN], 1u);
            else XB_SPIN(xb_ld(&bar[XB_TOPGEN]) == tg, bar);
            __builtin_amdgcn_fence(__ATOMIC_ACQUIRE, "agent");
            xb_add(&bar[XB_XGEN(b.x)], 1u);
            asm volatile("s_waitcnt vmcnt(0)" ::: "memory");
        } else {
            XB_SPIN(xb_ld(&bar[XB_XGEN(b.x)]) == gen, bar);
            __builtin_amdgcn_fence(__ATOMIC_ACQUIRE, "agent");
            asm volatile("s_waitcnt vmcnt(0)" ::: "memory");
        }
    }
    __syncthreads();
}
struct Args { const float* in[34]; float* out; unsigned char* ws; int ph_lo, ph_hi; };
enum { I_X = 0, I_P, I_RELB, I_GMIX, I_WIN, I_WGATE, I_BGATE, I_ARE, I_AIM, I_LOGDT, I_BRE, I_BIM, I_CRE, I_CIM, I_DSK, I_WGLU, I_BGLU, I_SINKS,
       I_WBRS, I_WBRA, I_WOUT, I_GFFN, I_WRG, I_BRG, I_WRE, I_BRE2, I_WEG, I_WEU, I_WED, I_GPLE, I_WPG, I_BPG, I_WPLE, I_GFIN };
constexpr int NPHASE = 14;

__device__ __forceinline__ void p0_transpose_item(const float* W, int N, bf16* WT, int ldt, int drow0, int k0, int n0, LAS float* scr, int lane) {
#pragma unroll 8
    for (int i = 0; i < 32; ++i) { const int kk = 2 * i + (lane >> 5); scr[kk * 33 + (lane & 31)] = W[(size_t)(k0 + kk) * N + n0 + (lane & 31)]; }
    LDS_WAIT(); asm volatile("" ::: "memory");
    const int c = lane & 7;
#pragma unroll
    for (int j = 0; j < 4; ++j) { const int n = (lane >> 3) + 8 * j; const LAS float* s = scr + (8 * c) * 33 + n;
        u32x4 o; o.x = pk2(s[0 * 33], s[1 * 33]); o.y = pk2(s[2 * 33], s[3 * 33]); o.z = pk2(s[4 * 33], s[5 * 33]); o.w = pk2(s[6 * 33], s[7 * 33]);
        *(u32x4*)(WT + (size_t)(drow0 + n) * ldt + k0 + 8 * c) = o; }
    LDS_WAIT(); asm volatile("" ::: "memory");
}
__device__ __forceinline__ void p0_tr_plain(const float* W, int K, int N, bf16* WT, int row_off, int item, LAS float* scr, int lane) {
    const int nblk = N / 32, kb = item / nblk, nb = item % nblk;
    p0_transpose_item(W, N, WT, K, row_off + 32 * nb, 64 * kb, 32 * nb, scr, lane);
}
struct Cplx { float re, im; };
__device__ __forceinline__ Cplx cmul(Cplx a, Cplx b) { return Cplx{a.re * b.re - a.im * b.im, a.re * b.im + a.im * b.re}; }
__device__ __forceinline__ Cplx apow(float are, float aim, float dt, int k) {
    const float mag = ex2((float)k * dt * are * LOG2E);
    const double rev = (double)k * (double)dt * (double)aim * 0.15915494309189535;
    const float fr = (float)(rev - __builtin_rint(rev));
    return Cplx{mag * __builtin_amdgcn_cosf(fr), mag * __builtin_amdgcn_sinf(fr)};
}
__device__ __forceinline__ void p0_ssm_params(const Args& a, LAS unsigned char* lds, int vb, int tid) {
    const int g = vb >> 3, sub = vb & 7;
    LAS float* cfr = (LAS float*)lds; LAS float* cfi = cfr + 64; LAS float* apr = cfr + 128; LAS float* api = apr + 17 * 64;
    const float dt = ex2(a.in[I_LOGDT][g] * LOG2E);
    for (int idx = tid; idx < 64 + 17 * 64; idx += 512) {
        if (idx < 64) {
            const int p = idx; const float are = a.in[I_ARE][g * 64 + p], aim = a.in[I_AIM][g * 64 + p];
            const Cplx z{are * dt, aim * dt}; const float z2 = z.re * z.re + z.im * z.im; Cplx cf;
            if (z2 < 0.01f) {
                Cplx s{1.f / 120.f, 0.f}; s = cmul(s, z); s.re += 1.f / 24.f; s = cmul(s, z); s.re += 1.f / 6.f; s = cmul(s, z); s.re += 0.5f; s = cmul(s, z); s.re += 1.f;
                cf = Cplx{s.re * dt, s.im * dt};
            } else {
                const Cplx ab = apow(are, aim, dt, 1); const Cplx num{ab.re - 1.f, ab.im}; const float inv = 1.f / (are * are + aim * aim);
                cf = Cplx{(num.re * are + num.im * aim) * inv, (num.im * are - num.re * aim) * inv};
            }
            cfr[p] = cf.re; cfi[p] = cf.im;
        } else {
            const int k = (idx - 64) >> 6, p = (idx - 64) & 63;
            const Cplx v = apow(a.in[I_ARE][g * 64 + p], a.in[I_AIM][g * 64 + p], dt, k);
            apr[k * 64 + p] = v.re; api[k * 64 + p] = v.im;
        }
    }
    __syncthreads();
    bf16* Bs = (bf16*)(a.ws + WS_BSSM); bf16* M1 = (bf16*)(a.ws + WS_M1T); float* A16 = (float*)(a.ws + WS_A16);
    const float* bre = a.in[I_BRE]; const float* bim = a.in[I_BIM]; const float* cre = a.in[I_CRE]; const float* cim = a.in[I_CIM];
    {
        const int tau = 2 * sub + (tid >> 8), c = (tid >> 4) & 15, c2 = tid & 15; float acc = 0.f;
        for (int p = 0; p < 64; ++p) {
            const Cplx w = cmul(Cplx{apr[tau * 64 + p], api[tau * 64 + p]}, Cplx{cfr[p], cfi[p]});
            const Cplx v = cmul(w, Cplx{bre[(g * 64 + p) * 16 + c2], bim[(g * 64 + p) * 16 + c2]});
            acc += cre[(g * 16 + c) * 64 + p] * v.re - cim[(g * 16 + c) * 64 + p] * v.im;
        }
        if (tau == 0 && c == c2) acc += a.in[I_DSK][g * 16 + c];
        const bf16 hv = (bf16)(pk2(acc, 0.f) & 0xffffu);
        for (int s = tau; s < 16; ++s) Bs[(size_t)(g * 256 + s * 16 + c) * 384 + (s - tau) * 16 + c2] = hv;
        if (tau > 0) for (int s = 0; s + tau < 16; ++s) Bs[(size_t)(g * 256 + s * 16 + c) * 384 + (s + tau) * 16 + c2] = 0;
    }
    {
        const int n = 32 * sub + (tid >> 4), pg = tid & 15, s = n >> 4, c = n & 15; float v[8];
#pragma unroll
        for (int q = 0; q < 4; ++q) { const int p = 4 * pg + q; const Cplx w = cmul(Cplx{cre[(g * 16 + c) * 64 + p], cim[(g * 16 + c) * 64 + p]}, Cplx{apr[(s + 1) * 64 + p], api[(s + 1) * 64 + p]});
            v[2 * q] = w.re; v[2 * q + 1] = -w.im; }
        u32x4 o; o.x = pk2(v[0], v[1]); o.y = pk2(v[2], v[3]); o.z = pk2(v[4], v[5]); o.w = pk2(v[6], v[7]);
        *(u32x4*)(Bs + (size_t)(g * 256 + n) * 384 + 256 + 8 * pg) = o;
    }
    {
        const int p = 8 * sub + (tid >> 6), s = (tid >> 2) & 15, cq = tid & 3;
        const Cplx w = cmul(Cplx{apr[(15 - s) * 64 + p], api[(15 - s) * 64 + p]}, Cplx{cfr[p], cfi[p]}); float vr[4], vi[4];
#pragma unroll
        for (int i = 0; i < 4; ++i) { const int c = 4 * cq + i; const Cplx v = cmul(w, Cplx{bre[(g * 64 + p) * 16 + c], bim[(g * 64 + p) * 16 + c]}); vr[i] = v.re; vi[i] = v.im; }
        u32x2 o; o.x = pk2(vr[0], vr[1]); o.y = pk2(vr[2], vr[3]); *(u32x2*)(M1 + (size_t)(g * 128 + 2 * p) * 256 + s * 16 + 4 * cq) = o;
        o.x = pk2(vi[0], vi[1]); o.y = pk2(vi[2], vi[3]); *(u32x2*)(M1 + (size_t)(g * 128 + 2 * p + 1) * 256 + s * 16 + 4 * cq) = o;
    }
    if (sub == 0 && tid < 64) { A16[(g * 64 + tid) * 2] = apr[16 * 64 + tid]; A16[(g * 64 + tid) * 2 + 1] = api[16 * 64 + tid]; }
    __syncthreads();
}
__device__ __forceinline__ void rms_row_to_bf16(const float* xrow, const float* gain, bf16* orow, int lane) {
    const f32x4* xr = (const f32x4*)xrow + lane; f32x4 v[4]; float s = 0.f;
#pragma unroll
    for (int j = 0; j < 4; ++j) { v[j] = xr[64 * j]; s += (v[j][0] * v[j][0] + v[j][1] * v[j][1]) + (v[j][2] * v[j][2] + v[j][3] * v[j][3]); }
    const float rs = __builtin_amdgcn_rsqf(wave_sum(s) * (1.0f / 1024.0f) + RMS_EPS);
    u32x2* o8 = (u32x2*)orow + lane;
#pragma unroll
    for (int j = 0; j < 4; ++j) { const f32x4 gq = ((const f32x4*)gain)[lane + 64 * j]; u32x2 o; o.x = pk2(v[j][0] * rs * gq[0], v[j][1] * rs * gq[1]); o.y = pk2(v[j][2] * rs * gq[2], v[j][3] * rs * gq[3]); o8[64 * j] = o; }
}
__device__ __forceinline__ void p0_prologue(const Args& a, LAS unsigned char* lds, int tid, int lane, int wave) {
    const int G = gridDim.x;
    for (int vb = blockIdx.x; vb < 256; vb += G) p0_ssm_params(a, lds, vb, tid);
    {
        bf16* Wr = (bf16*)(a.ws + WS_WR); const float* wrg = a.in[I_WRG]; const float* wre = a.in[I_WRE];
        for (int e = (blockIdx.x * 512 + tid) * 2; e < 256 * 1024; e += G * 1024) { const int n = e >> 10, k = e & 1023; float v0 = 0.f, v1 = 0.f;
            if (n < 4) { v0 = wrg[k * 4 + n]; v1 = wrg[(k + 1) * 4 + n]; } else if (n < 36) { v0 = wre[k * 32 + n - 4]; v1 = wre[(k + 1) * 32 + n - 4]; }
            *(unsigned*)(Wr + e) = pk2(v0, v1); }
    }
    LAS float* scr = (LAS float*)(lds + wave * 16384);
    const int gw = blockIdx.x * NWAVES + wave, NGW = G * NWAVES;
    bf16* Wcat = (bf16*)(a.ws + WS_WCAT);
    constexpr int I_IN = 16 * 40, I_GATE = 16 * 64, I_GLU = 8 * 16, I_BR = 8 * 32, I_SQ = 16 * 32, I_PLE = 4 * 32, I_EXP = 256;
    constexpr int NITEMS = I_IN + I_GATE + I_GLU + 2 * I_BR + 2 * I_SQ + I_PLE + 96 * I_EXP;
    for (int it = gw; it < NITEMS; it += NGW) {
        int r = it;
        if (r < I_IN) { p0_tr_plain(a.in[I_WIN], 1024, 1280, Wcat, 0, r, scr, lane); continue; } r -= I_IN;
        if (r < I_GATE) { p0_tr_plain(a.in[I_WGATE], 1024, 2048, Wcat, 1280, r, scr, lane); continue; } r -= I_GATE;
        if (r < I_GLU) { p0_tr_plain(a.in[I_WGLU], 512, 512, (bf16*)(a.ws + WS_WGLU), 0, r, scr, lane); continue; } r -= I_GLU;
        if (r < I_BR) { p0_tr_plain(a.in[I_WBRS], 512, 1024, (bf16*)(a.ws + WS_WA), 0, r, scr, lane); continue; } r -= I_BR;
        if (r < I_BR) { p0_tr_plain(a.in[I_WBRA], 512, 1024, (bf16*)(a.ws + WS_WB), 0, r, scr, lane); continue; } r -= I_BR;
        if (r < I_SQ) { p0_tr_plain(a.in[I_WOUT], 1024, 1024, (bf16*)(a.ws + WS_WOUT), 0, r, scr, lane); continue; } r -= I_SQ;
        if (r < I_SQ) { p0_tr_plain(a.in[I_WPG], 1024, 1024, (bf16*)(a.ws + WS_WPG), 0, r, scr, lane); continue; } r -= I_SQ;
        if (r < I_PLE) { p0_tr_plain(a.in[I_WPLE], 256, 1024, (bf16*)(a.ws + WS_WPLE), 0, r, scr, lane); continue; } r -= I_PLE;
        const int em = r >> 8, it2 = r & 255, e = em / 3, which = em % 3;
        if (which == 2) {
            p0_tr_plain(a.in[I_WED] + (size_t)e * 512 * 1024, 512, 1024, (bf16*)(a.ws + WS_WD) + (size_t)e * 1024 * 512, 0, it2, scr, lane);
        } else {
            const int kb = it2 >> 4, nb = it2 & 15, n0 = 32 * nb;
            p0_transpose_item(a.in[which == 0 ? I_WEG : I_WEU] + (size_t)e * 1024 * 512, 512, (bf16*)(a.ws + WS_WGU) + (size_t)e * 1024 * 1024, 1024, 256 * (n0 >> 7) + 128 * which + (n0 & 127), 64 * kb, n0, scr, lane);
        }
    }
    bf16* H = (bf16*)(a.ws + WS_R1);
    for (int m = gw; m < TOK; m += NGW) rms_row_to_bf16(a.in[I_X] + (size_t)m * 1024, a.in[I_GMIX], H + (size_t)m * 1024, lane);
    {
        const f32x4* P = (const f32x4*)a.in[I_P]; u32x4* PB = (u32x4*)(a.ws + WS_PB);
        for (int i = gw * 64 + lane; i < TOK * 256 / 8; i += NGW * 64) { const f32x4 v0 = P[2 * i], v1 = P[2 * i + 1]; PB[i] = pack8(v0, v1); }
    }
}

__device__ __forceinline__ void ssm_scan_unit(const Args& a, LAS unsigned char* lds, int unit, int tid, int lane, int wave) {
    const int g = unit >> 3, b = unit & 7, r32 = lane & 31, hi = lane >> 5;
    bf16* Arow = (bf16*)(a.ws + WS_ASSM) + (size_t)(g * 2048 + b * 256) * 384;
    const bf16* M1 = (const bf16*)(a.ws + WS_M1T) + (size_t)g * 128 * 256;
    LAS float* sloc = (LAS float*)lds;
    LAS float* segend = (LAS float*)(lds + EXTRA_OFF + 2048);
    {
        f32x16 acc[4];
#pragma unroll
        for (int nt = 0; nt < 4; ++nt)
#pragma unroll
            for (int i = 0; i < 16; ++i) acc[nt][i] = 0.f;
        const bf16* ap = Arow + (size_t)(32 * wave + r32) * 384 + 8 * hi;
        const bf16* bp = M1 + (size_t)r32 * 256 + 8 * hi;
#pragma unroll 4
        for (int ks = 0; ks < 16; ++ks) {
            const bf16x8 af = *(const bf16x8*)(ap + 16 * ks);
#pragma unroll
            for (int nt = 0; nt < 4; ++nt) { const bf16x8 bfr = *(const bf16x8*)(bp + (size_t)nt * 32 * 256 + 16 * ks); acc[nt] = __builtin_amdgcn_mfma_f32_32x32x16_bf16(af, bfr, acc[nt], 0, 0, 0); }
        }
#pragma unroll
        for (int nt = 0; nt < 4; ++nt)
#pragma unroll
            for (int i = 0; i < 16; ++i) { const int j = 32 * wave + (i & 3) + 8 * (i >> 2) + 4 * hi; sloc[j * 128 + nt * 32 + r32] = acc[nt][i]; }
    }
    __syncthreads();
    const int p = tid & 63, seg = tid >> 6;
    const float* A16 = (const float*)(a.ws + WS_A16) + (g * 64 + p) * 2;
    const Cplx a16{A16[0], A16[1]};
    Cplx st{0.f, 0.f};
    for (int j = seg * 32; j < seg * 32 + 32; ++j) { const Cplx s{sloc[j * 128 + 2 * p], sloc[j * 128 + 2 * p + 1]}; st = cmul(a16, st); st.re += s.re; st.im += s.im; }
    segend[(seg * 64 + p) * 2] = st.re; segend[(seg * 64 + p) * 2 + 1] = st.im;
    Cplx a512 = a16;
#pragma unroll
    for (int i = 0; i < 5; ++i) a512 = cmul(a512, a512);
    __syncthreads();
    st = Cplx{0.f, 0.f};
    for (int s2 = 0; s2 < seg; ++s2) { st = cmul(a512, st); st.re += segend[(s2 * 64 + p) * 2]; st.im += segend[(s2 * 64 + p) * 2 + 1]; }
    for (int j = seg * 32; j < seg * 32 + 32; ++j) {
        *(unsigned*)(Arow + (size_t)j * 384 + 256 + 2 * p) = pk2(st.re, st.im);
        const Cplx s{sloc[j * 128 + 2 * p], sloc[j * 128 + 2 * p + 1]}; st = cmul(a16, st); st.re += s.re; st.im += s.im;
    }
    __syncthreads();
}

__device__ const unsigned char T5_BUCKET[128] = {0, 1, 2, 3, 4, 5, 6, 7, 8, 9, 10, 11, 12, 13, 14, 15, 16, 16, 16, 17, 17, 18, 18, 18, 19, 19, 19, 20, 20, 20, 20, 21, 21, 21, 21, 22, 22, 22, 22, 22, 23, 23, 23, 23, 23, 23, 24, 24, 24, 24, 24, 24, 25, 25, 25, 25, 25, 25, 25, 26, 26, 26, 26, 26, 26, 26, 26, 27, 27, 27, 27, 27, 27, 27, 27, 27, 27, 28, 28, 28, 28, 28, 28, 28, 28, 28, 28, 29, 29, 29, 29, 29, 29, 29, 29, 29, 29, 29, 29, 30, 30, 30, 30, 30, 30, 30, 30, 30, 30, 30, 30, 30, 30, 31, 31, 31, 31, 31, 31, 31, 31, 31, 31, 31, 31, 31, 31, 31};
__device__ __forceinline__ void attn_unit(const Args& a, LAS unsigned char* lds, int unit, int tid_in, int lane_in, int wave) {
    int tid = tid_in; asm volatile("" : "+v"(tid)); const int lane = tid & 63;
    const int b = unit >> 6, blk = (unit >> 1) & 31, kvh = unit & 1, r32 = lane & 31, hi = lane >> 5;
    const bf16* qkv = (const bf16*)(a.ws + WS_QKV); bf16* yatt = (bf16*)(a.ws + WS_YATT);
    const size_t tok0 = (size_t)b * SEQ + (size_t)blk * 128;
    LAS unsigned char* Kl = lds; LAS unsigned char* Vl = lds + 32768; LAS float* bl = (LAS float*)(lds + 65536);
    const u32x4 zero4 = {0u, 0u, 0u, 0u};
#pragma unroll
    for (int i = 0; i < 4; ++i) { const int key = tid & 255, ch = (tid >> 8) + 2 * i;
        u32x4 v = zero4; if (blk > 0 || key >= 128) v = *(const u32x4*)(qkv + (tok0 - 128 + key) * 768 + 512 + kvh * 64 + ch * 8);
        *(LAS u32x4*)(Kl + (ch * 256 + key) * 16) = v; }
#pragma unroll
    for (int i = 0; i < 4; ++i) { const int pidx = tid + 512 * i, key = pidx >> 3, rem = pidx & 7, dh = rem >> 2, q4 = rem & 3;
        u32x4 v = zero4; if (blk > 0 || key >= 128) v = *(const u32x4*)(qkv + (tok0 - 128 + key) * 768 + 640 + kvh * 64 + dh * 32 + q4 * 8);
        *(LAS u32x4*)(Vl + dh * 16384 + key * 64 + q4 * 16) = v; }
    for (int idx = tid; idx < 4 * 192; idx += 512) { const int hl = idx / 192, rel = idx % 192 - 32;
        bl[idx] = (rel >= 0 && rel < 128) ? a.in[I_RELB][T5_BUCKET[rel] * 8 + kvh * 4 + hl] * LOG2E : -INFINITY; }
    __syncthreads();
    const int hl = wave >> 1, head = kvh * 4 + hl;
    const float sink2 = a.in[I_SINKS][head] * LOG2E;
    const LAS float* blane = bl + hl * 192 + 32 + 128 + r32 - 4 * hi;
    const int vlane = ((lane >> 4) & 1) * 32 + (lane & 3) * 8 + (4 * hi + ((lane & 15) >> 2)) * 64;
    for (int qb = 0; qb < 2; ++qb) {
        const int qi = (wave & 1) * 2 + qb;
        const size_t tq = tok0 + qi * 32 + r32;
        bf16x8 qr[4];
#pragma unroll
        for (int d0 = 0; d0 < 4; ++d0) qr[d0] = *(const bf16x8*)(qkv + tq * 768 + head * 64 + d0 * 16 + hi * 8);
        f32x16 p[5];
        float mx = sink2;
#pragma unroll
        for (int kt = 0; kt < 5; ++kt) {
#pragma unroll
            for (int i = 0; i < 16; ++i) p[kt][i] = 0.f;
            const LAS unsigned char* kp = Kl + (hi * 256 + 32 * (qi + kt) + r32) * 16;
#pragma unroll
            for (int d0 = 0; d0 < 4; ++d0) { const bf16x8 kf = *(const LAS bf16x8*)(kp + d0 * 8192); p[kt] = __builtin_amdgcn_mfma_f32_32x32x16_bf16(kf, qr[d0], p[kt], 0, 0, 0); }
            const bool tile_ok = (blk > 0) || (qi + kt >= 4);
#pragma unroll
            for (int i = 0; i < 16; ++i) { const float bq = blane[-32 * kt - ((i & 3) + 8 * (i >> 2))];
                const float sv = tile_ok ? p[kt][i] + bq : -INFINITY; p[kt][i] = sv; mx = fmaxf(mx, sv); }
            __builtin_amdgcn_sched_barrier(0);
        }
        mx = fmaxf(mx, __shfl_xor(mx, 32));
        float sum = 0.f;
        f32x16 o[2];
#pragma unroll
        for (int dh = 0; dh < 2; ++dh)
#pragma unroll
            for (int i = 0; i < 16; ++i) o[dh][i] = 0.f;
#pragma unroll
        for (int kt = 0; kt < 5; ++kt) {
#pragma unroll
            for (int i = 0; i < 16; ++i) { const float e = ex2(p[kt][i] - mx); p[kt][i] = e; sum += e; }
#pragma unroll
            for (int s2 = 0; s2 < 2; ++s2) {
                u32x4 pw; pw.x = pk2(p[kt][8 * s2 + 0], p[kt][8 * s2 + 1]); pw.y = pk2(p[kt][8 * s2 + 2], p[kt][8 * s2 + 3]); pw.z = pk2(p[kt][8 * s2 + 4], p[kt][8 * s2 + 5]); pw.w = pk2(p[kt][8 * s2 + 6], p[kt][8 * s2 + 7]);
                const bf16x8 pa = __builtin_bit_cast(bf16x8, pw);
#pragma unroll
                for (int dh = 0; dh < 2; ++dh) { LAS unsigned char* vp = Vl + dh * 16384 + (32 * (qi + kt) + 16 * s2) * 64 + vlane;
                    const v4i16_t lo = __builtin_amdgcn_ds_read_tr16_b64_v4i16((LAS v4i16_t*)vp), hh = __builtin_amdgcn_ds_read_tr16_b64_v4i16((LAS v4i16_t*)(vp + 512));
                    const bf16x8 vb = (bf16x8){lo[0], lo[1], lo[2], lo[3], hh[0], hh[1], hh[2], hh[3]};
                    o[dh] = __builtin_amdgcn_mfma_f32_32x32x16_bf16(pa, vb, o[dh], 0, 0, 0); }
            }
            __builtin_amdgcn_sched_barrier(0);
        }
        sum += __shfl_xor(sum, 32); sum += ex2(sink2 - mx);
        const float rinv = 1.0f / sum;
#pragma unroll
        for (int i = 0; i < 16; ++i) { const int cr = (i & 3) + 8 * (i >> 2) + 4 * hi; const float ri = __shfl(rinv, cr);
            bf16* orow = yatt + (tok0 + qi * 32 + cr) * 512 + head * 64 + r32;
            orow[0] = (bf16)(pk2(o[0][i] * ri, 0.f) & 0xffffu); orow[32] = (bf16)(pk2(o[1][i] * ri, 0.f) & 0xffffu); }
        __builtin_amdgcn_sched_barrier(0);
    }
    __syncthreads();
}

__device__ __forceinline__ void moe_offsets(const Args& a, LAS int* pad, int tid) {
    gu32* ctl = (gu32*)(a.ws + WS_CTL);
    if (tid == 0) { int acc = 0;
        for (int e = 0; e < 32; ++e) { pad[e] = acc; const int c = (int)__hip_atomic_load(ctl + CW_CNT + e, RLX_AGENT); acc += ((c + 255) >> 8) << 8; }
        pad[32] = acc; }
    __syncthreads();
}
__device__ __forceinline__ void p8_scatter(const Args& a, LAS unsigned char* lds, int tid, int lane, int wave) {
    LAS int* pad = (LAS int*)(lds + EXTRA_OFF + 8192);
    moe_offsets(a, pad, tid);
    gu32* ctl = (gu32*)(a.ws + WS_CTL);
    if (blockIdx.x == 0) { const int nblk = pad[32] >> 8; if (tid == 0) ctl[CW_BLK] = (unsigned)nblk;
        for (int rb = tid; rb < nblk; rb += 512) { int e = 0; for (int q = 1; q < 32; ++q) if ((rb << 8) >= pad[q]) e = q;
            ctl[CW_BLK + 1 + rb] = (unsigned)e; } }
    const int* slot_e = (const int*)(a.ws + WS_SLOT_E); const int* slot_pos = (const int*)(a.ws + WS_SLOT_POS); const float* slot_w = (const float*)(a.ws + WS_SLOT_W);
    int* slot_dest = (int*)(a.ws + WS_SLOT_DEST); float* dw = (float*)(a.ws + WS_DEST_W); float* drs = (float*)(a.ws + WS_DEST_RSTD);
    const float* rstd1 = (const float*)(a.ws + WS_RSTD1);
    const bf16* xg = (const bf16*)(a.ws + WS_R1); bf16* xd = (bf16*)(a.ws + WS_XD);
    const int gw = blockIdx.x * NWAVES + wave, NGW = gridDim.x * NWAVES;
    for (int sl = gw; sl < NSLOT; sl += NGW) { const int t = sl >> 1, e = slot_e[sl], dest = pad[e] + slot_pos[sl];
        const u32x4* src = (const u32x4*)(xg + (size_t)t * 1024); u32x4* dst = (u32x4*)(xd + (size_t)dest * 1024);
        const u32x4 v0 = src[lane], v1 = src[lane + 64]; dst[lane] = v0; dst[lane + 64] = v1;
        if (lane == 0) { slot_dest[sl] = dest; dw[dest] = slot_w[sl]; drs[dest] = rstd1[t]; } }
}
__device__ __forceinline__ void moe_load_blk(const Args& a, LAS int* blk, int tid) {
    gu32* ctl = (gu32*)(a.ws + WS_CTL);
    for (int i = tid; i < 1 + MAXBLK; i += 512) blk[i] = (int)__hip_atomic_load(ctl + CW_BLK + i, RLX_AGENT);
    __syncthreads();
}
__device__ __forceinline__ void p11_combine(const Args& a, int lane, int wave) {
    const int gw = blockIdx.x * NWAVES + wave, NGW = gridDim.x * NWAVES;
    const int* slot_dest = (const int*)(a.ws + WS_SLOT_DEST); const bf16* yd = (const bf16*)(a.ws + WS_XD); const bf16* x1g = (const bf16*)(a.ws + WS_R1); bf16* x2g = (bf16*)(a.ws + WS_ACT); float* rstd2 = (float*)(a.ws + WS_RSTD2);
    f32x4 gi[4], go[4];
#pragma unroll
    for (int j = 0; j < 4; ++j) { const f32x4 g1 = ((const f32x4*)a.in[I_GFFN])[lane + 64 * j]; go[j] = ((const f32x4*)a.in[I_GPLE])[lane + 64 * j];
#pragma unroll
        for (int i = 0; i < 4; ++i) gi[j][i] = 1.0f / g1[i]; }
    for (int t = gw; t < TOK; t += NGW) { const int d0 = slot_dest[2 * t], d1 = slot_dest[2 * t + 1];
        const u32x2* xr = (const u32x2*)(x1g + (size_t)t * 1024) + lane; const u32x2* y0 = (const u32x2*)(yd + (size_t)d0 * 1024) + lane; const u32x2* y1 = (const u32x2*)(yd + (size_t)d1 * 1024) + lane;
        f32x4 v[4]; float s = 0.f;
#pragma unroll
        for (int j = 0; j < 4; ++j) { const u32x2 xw = xr[64 * j], p0 = y0[64 * j], p1 = y1[64 * j];
            v[j][0] = bflo(xw.x) * gi[j][0] + (bflo(p0.x) + bflo(p1.x)); v[j][1] = bfhi(xw.x) * gi[j][1] + (bfhi(p0.x) + bfhi(p1.x));
            v[j][2] = bflo(xw.y) * gi[j][2] + (bflo(p0.y) + bflo(p1.y)); v[j][3] = bfhi(xw.y) * gi[j][3] + (bfhi(p0.y) + bfhi(p1.y));
            s += (v[j][0] * v[j][0] + v[j][1] * v[j][1]) + (v[j][2] * v[j][2] + v[j][3] * v[j][3]); }
        const float tot = wave_sum(s); if (lane == 0) rstd2[t] = __builtin_amdgcn_rsqf(tot * (1.0f / 1024.0f) + RMS_EPS);
        u32x2* o8 = (u32x2*)(x2g + (size_t)t * 1024) + lane;
#pragma unroll
        for (int j = 0; j < 4; ++j) { u32x2 o; o.x = pk2(v[j][0] * go[j][0], v[j][1] * go[j][1]); o.y = pk2(v[j][2] * go[j][2], v[j][3] * go[j][3]); o8[64 * j] = o; } }
}
__device__ __forceinline__ void p13_final(const Args& a, int lane, int wave) {
    const int gw = blockIdx.x * NWAVES + wave, NGW = gridDim.x * NWAVES; const float* gain = a.in[I_GFIN];
    const bf16* x3h = (const bf16*)(a.ws + WS_R1); const float* rss = (const float*)(a.ws + WS_RSS1);
    f32x4 gq[4];
#pragma unroll
    for (int j = 0; j < 4; ++j) gq[j] = ((const f32x4*)gain)[lane + 64 * j];
    for (int t = gw; t < TOK; t += NGW) {
        float s = (lane < 16) ? rss[(size_t)t * 16 + lane] : 0.f;
        s += __shfl_xor(s, 1); s += __shfl_xor(s, 2); s += __shfl_xor(s, 4); s += __shfl_xor(s, 8); s = __shfl(s, 0);
        const float rs = __builtin_amdgcn_rsqf(s * (1.0f / 1024.0f) + RMS_EPS);
        const u32x2* xr = (const u32x2*)(x3h + (size_t)t * 1024) + lane; f32x4* orow = (f32x4*)(a.out + (size_t)t * 1024) + lane;
#pragma unroll
        for (int j = 0; j < 4; ++j) { const u32x2 xw = xr[64 * j]; f32x4 v; v[0] = bflo(xw.x); v[1] = bfhi(xw.x); v[2] = bflo(xw.y); v[3] = bfhi(xw.y); orow[64 * j] = v * rs * gq[j]; } }
}

__global__ void __launch_bounds__(NWAVES * 64, 2) fwd_kernel(Args args) {
    extern __shared__ __attribute__((aligned(16))) unsigned char lds_raw[];
    LAS unsigned char* lds = (LAS unsigned char*)lds_raw;
#define FRESH_TID() int tid_f = threadIdx.x; asm volatile("" : "+v"(tid_f)); const int tid = tid_f, lane = tid & 63, wave = __builtin_amdgcn_readfirstlane(tid >> 6); (void)lane; (void)wave
    const int G = gridDim.x, bx = blockIdx.x;
    const int vcu = (G % 8 == 0) ? (bx % 8) * (G / 8) + bx / 8 : bx;
    unsigned char* ws = args.ws;
    gu32* ctl = (gu32*)(ws + WS_CTL);
    for (int u = threadIdx.x; u < (LDS_BYTES - LDSCTL_OFF) / 4; u += NWAVES * 64) ((LAS unsigned*)(lds + LDSCTL_OFF))[u] = 0u;
    __syncthreads();
    const int lo = args.ph_lo, hi = args.ph_hi;
    const bool use_bar = (hi - lo) > 1;
    XcdBarrier bar; bar.bar = (unsigned*)(ctl + CW_BAR); bar.x = 0; bar.st = nullptr;
    if (use_bar) bar = xcd_barrier_post((unsigned*)(ctl + CW_BAR), (volatile LAS unsigned*)(lds + MISC_OFF) + 8);
#ifndef PHASE_MASK
#define PHASE_MASK 0x3fff
#endif
#define IN(k) (((PHASE_MASK >> (k)) & 1) && lo <= (k) && (k) < hi)
#ifdef PROBE_A
#define STAMP(k) do { if (blockIdx.x == 0 && threadIdx.x == 0) ((unsigned long long*)(ws + WS_A16 + 65536))[(k) + 1] = __builtin_amdgcn_s_memrealtime(); } while (0)
#else
#define STAMP(k) do { } while (0)
#endif
#ifndef REPEAT_MASK
#define REPEAT_MASK 0
#endif
#ifndef EXTRA_BARS
#define EXTRA_BARS 0
#endif
#define NREP(k) (((REPEAT_MASK >> (k)) & 1) ? 2 : 1)
#define SEAM(k) do { if (IN(k) && IN((k) + 1)) { xcd_barrier(bar); for (int eb_ = 0; eb_ < EXTRA_BARS; ++eb_) xcd_barrier(bar); } STAMP(k); } while (0)

    bf16* const R1 = (bf16*)(ws + WS_R1);
    STAMP(-1);

    if (IN(0)) for (int rep_ = 0; rep_ < NREP(0); ++rep_) { FRESH_TID(); p0_prologue(args, lds, tid, lane, wave); }
    SEAM(0);
    if (IN(1)) for (int rep_ = 0; rep_ < NREP(1); ++rep_) {
        pg8::Gemm g{R1, (const bf16*)(ws + WS_WCAT), TOK, 3328, 1024}; pg8::StaticOrder S; S.init(TOK, 3328, G, bx);
        Epi1 E{(bf16*)(ws + WS_ASSM), (bf16*)(ws + WS_QKV), (bf16*)(ws + WS_GATES), args.in[I_BGATE]};
        pg8::gemm_phase<Epi1, pg8::StaticOrder, true, true>(lds + RING_OFF, g, S, E);
    }
    SEAM(1);
    if (IN(2)) for (int rep_ = 0; rep_ < NREP(2); ++rep_) {
        FRESH_TID();
#ifndef NO_SCAN
        for (int u = vcu; u < 256; u += G) ssm_scan_unit(args, lds, u, tid, lane, wave);
#endif
#ifndef NO_ATTN
        for (int u = vcu; u < 512; u += G) attn_unit(args, lds, u, tid, lane, wave);
#endif
    }
    SEAM(2);
    if (IN(3)) for (int rep_ = 0; rep_ < NREP(3); ++rep_) {
        {
            pg8::Gemm g{(const bf16*)(ws + WS_ASSM), (const bf16*)(ws + WS_BSSM), 65536, 8192, 384};
#ifndef NO_SSMG
            OneUnit S{vcu, vcu >> 3, vcu < 256};
            EpiSsm E{(bf16*)(ws + WS_YG)};
            pg8::gemm_phase<EpiSsm, OneUnit, false, true>(lds + RING_OFF, g, S, E);
#endif
        }
        {
#ifndef NO_BRB
            pg8::Gemm g{(const bf16*)(ws + WS_YATT), (const bf16*)(ws + WS_WB), TOK, 1024, 512}; pg8::StaticOrder S; S.init(TOK, 1024, G, bx);
            EpiBranch<false> E{(const bf16*)(ws + WS_GATES), 1024, nullptr, R1};
            pg8::gemm_phase<EpiBranch<false>, pg8::StaticOrder, true, true>(lds + RING_OFF, g, S, E);
#endif
        }
    }
    SEAM(3);
    if (IN(4)) for (int rep_ = 0; rep_ < NREP(4); ++rep_) {
        pg8::Gemm g{(const bf16*)(ws + WS_YG), (const bf16*)(ws + WS_WGLU), TOK, 512, 512}; pg8::StaticOrder S; S.init(TOK, 512, G, bx);
        EpiGlu E{(const bf16*)(ws + WS_YG), (bf16*)(ws + WS_YATT), args.in[I_BGLU]};
        pg8::gemm_phase<EpiGlu, pg8::StaticOrder, true, true>(lds + RING_OFF, g, S, E);
    }
    SEAM(4);
    if (IN(5)) for (int rep_ = 0; rep_ < NREP(5); ++rep_) {
        pg8::Gemm g{(const bf16*)(ws + WS_YATT), (const bf16*)(ws + WS_WA), TOK, 1024, 512}; pg8::StaticOrder S; S.init(TOK, 1024, G, bx);
        EpiBranch<true> E{(const bf16*)(ws + WS_GATES), 0, R1, (bf16*)(ws + WS_MERGED)};
        pg8::gemm_phase<EpiBranch<true>, pg8::StaticOrder, true, true>(lds + RING_OFF, g, S, E);
    }
    SEAM(5);
    if (IN(6)) for (int rep_ = 0; rep_ < NREP(6); ++rep_) {
        pg8::Gemm g{(const bf16*)(ws + WS_MERGED), (const bf16*)(ws + WS_WOUT), TOK, 1024, 1024}; pg8::StaticOrder S; S.init(TOK, 1024, G, bx);
        EpiWout E{args.in[I_X], R1, args.in[I_GFFN], (float*)(ws + WS_RSS1)};
        pg8::gemm_phase<EpiWout, pg8::StaticOrder, true, true>(lds + RING_OFF, g, S, E);
    }
    SEAM(6);
    if (IN(7)) for (int rep_ = 0; rep_ < NREP(7); ++rep_) {
        const int half = G / 2;
        if (bx < half) {
            pg8::Gemm g{R1, (const bf16*)(ws + WS_WR), TOK, 256, 1024};
            EpiRouter E{(const float*)(ws + WS_RSS1), (float*)(ws + WS_RSTD1), args.in[I_BRG], args.in[I_BRE2], (unsigned*)(ctl + CW_CNT), (int*)(ws + WS_SLOT_E), (int*)(ws + WS_SLOT_POS), (float*)(ws + WS_SLOT_W)};
            for (int pm = bx; pm < 128; pm += half) { OneUnit S{pm, 0, true}; pg8::gemm_phase<EpiRouter, OneUnit, false, true>(lds + RING_OFF, g, S, E); __syncthreads(); }
        } else {
            pg8::Gemm g{(const bf16*)(ws + WS_PB), (const bf16*)(ws + WS_WPLE), TOK, 1024, 256}; pg8::StaticOrder S; S.init(TOK, 1024, G - half, bx - half);
            EpiPlain E{(bf16*)(ws + WS_PP), 1024};
            pg8::gemm_phase<EpiPlain, pg8::StaticOrder, true, true>(lds + RING_OFF, g, S, E);
        }
    }
    SEAM(7);
    if (IN(8)) for (int rep_ = 0; rep_ < NREP(8); ++rep_) { FRESH_TID(); p8_scatter(args, lds, tid, lane, wave); }
    SEAM(8);
    if (IN(9)) for (int rep_ = 0; rep_ < NREP(9); ++rep_) {
        FRESH_TID(); LAS int* blk = (LAS int*)(lds + EXTRA_OFF); moe_load_blk(args, blk, tid);
        pg8::Gemm g{(const bf16*)(ws + WS_XD), (const bf16*)(ws + WS_WGU), MAXROWS, 32 * 1024, 1024};
        MoeOrder S{__builtin_amdgcn_readfirstlane(blk[0]) * 4, G, vcu, blk};
        EpiMoe1 E{(bf16*)(ws + WS_ACT), (const float*)(ws + WS_DEST_RSTD)};
        pg8::gemm_phase<EpiMoe1, MoeOrder, true, true>(lds + RING_OFF, g, S, E);
    }
    SEAM(9);
    if (IN(10)) for (int rep_ = 0; rep_ < NREP(10); ++rep_) {
        FRESH_TID(); LAS int* blk = (LAS int*)(lds + EXTRA_OFF); moe_load_blk(args, blk, tid);
        pg8::Gemm g{(const bf16*)(ws + WS_ACT), (const bf16*)(ws + WS_WD), MAXROWS, 32 * 1024, 512};
        MoeOrder S{__builtin_amdgcn_readfirstlane(blk[0]) * 4, G, vcu, blk};
        EpiMoe2 E{(bf16*)(ws + WS_XD), (const float*)(ws + WS_DEST_W)};
        pg8::gemm_phase<EpiMoe2, MoeOrder, true, true>(lds + RING_OFF, g, S, E);
    }
    SEAM(10);
    if (IN(11)) for (int rep_ = 0; rep_ < NREP(11); ++rep_) { FRESH_TID(); p11_combine(args, lane, wave); }
    SEAM(11);
    if (IN(12)) for (int rep_ = 0; rep_ < NREP(12); ++rep_) {
        pg8::Gemm g{(const bf16*)(ws + WS_ACT), (const bf16*)(ws + WS_WPG), TOK, 1024, 1024}; pg8::StaticOrder S; S.init(TOK, 1024, G, bx);
        EpiPle E{(const bf16*)(ws + WS_ACT), args.in[I_GPLE], (const bf16*)(ws + WS_PP), (const float*)(ws + WS_RSTD2), args.in[I_BPG], R1, (float*)(ws + WS_RSS1)};
        pg8::gemm_phase<EpiPle, pg8::StaticOrder, true, true>(lds + RING_OFF, g, S, E);
    }
    SEAM(12);
    if (IN(13)) for (int rep_ = 0; rep_ < NREP(13); ++rep_) { FRESH_TID(); p13_final(args, lane, wave); }
#ifdef PROBE_A
    xcd_barrier(bar); STAMP(13); xcd_barrier(bar);
    {
        const unsigned long long* ts = (const unsigned long long*)(ws + WS_A16 + 65536);
        const float usA = (float)(ts[PROBE_A + 1] - ts[PROBE_A]) * 0.01f, usB = (PROBE_B >= 0) ? (float)(ts[PROBE_B + 1] - ts[PROBE_B]) * 0.01f : (float)(ts[14] - ts[0]) * 0.01f;
        const float sc = 1.0f + usA * (1.0f / 300.0f);
        f32x4* o4 = (f32x4*)args.out;
        for (size_t i = (size_t)bx * 512 + threadIdx.x; i < (size_t)TOK * 256; i += (size_t)G * 512) { f32x4 v = o4[i] * sc; if (i == 0) v[0] = usB; o4[i] = v; }
    }
#endif

#ifdef DUMP_LEVEL
    if (lo <= 14 && 14 < hi) {
        const size_t n = (size_t)TOK * 1024;
        for (size_t i = (size_t)bx * 512 + threadIdx.x; i < n; i += (size_t)G * 512) {
            float v = 0.f;
            auto B = [&](size_t off, size_t cnt) { const bf16* p = (const bf16*)(ws + off); return __uint_as_float((unsigned)p[i % cnt] << 16); };
            if (DUMP_LEVEL == 0) { v += B(WS_R1, n) + B(WS_WCAT, 3328 * 1024) + B(WS_WGU, 32u * 1024 * 1024) + B(WS_WD, 16u * 1024 * 1024) + B(WS_BSSM, 8192 * 384) + B(WS_M1T, 32 * 128 * 256)
                                      + B(WS_WR, 256 * 1024) + B(WS_WOUT, 1024 * 1024) + B(WS_WPG, 1024 * 1024) + B(WS_WA, 512 * 1024) + B(WS_WB, 512 * 1024) + B(WS_WGLU, 512 * 512) + B(WS_WPLE, 256 * 1024) + B(WS_PB, (size_t)TOK * 256)
                                      + ((const float*)(ws + WS_A16))[i % 4096]; }
            if (DUMP_LEVEL >= 1) { v += B(WS_QKV, (size_t)TOK * 768) + B(WS_GATES, n) + B(WS_GATES + 2 * n, n);
                                   const size_t row = (i >> 8) & 65535, col = i & 255; v += __uint_as_float((unsigned)((const bf16*)(ws + WS_ASSM))[row * 384 + col] << 16); }
            if (DUMP_LEVEL >= 2) { v += B(WS_YATT, (size_t)TOK * 512);
                                   const size_t row = (i >> 7) & 65535, col = 256 + (i & 127); v += __uint_as_float((unsigned)((const bf16*)(ws + WS_ASSM))[row * 384 + col] << 16); }
            if (DUMP_LEVEL == 3) { v += B(WS_YG, (size_t)TOK * 512) + B(WS_R1, n); }
            args.out[i] = v;
        }
    }
#endif
#undef IN
#undef SEAM
}

#ifndef MK_N_LAUNCHES
#define MK_N_LAUNCHES 1
#endif
#ifndef RUN_MASK
#define RUN_MASK 0x3fff
#endif
extern "C" void kernel_launch(void* const* d_in, const int* in_sizes, int n_in, void* d_out, int out_size, void* d_ws, size_t ws_size, hipStream_t stream) {
    static int grid = 0;
    if (grid == 0) {
        if (n_in != 34 || in_sizes[0] != TOK * DM || out_size != TOK * DM || ws_size < WS_END) {
            fprintf(stderr, "kernel_launch: unexpected shapes (n_in %d, in0 %d, out %d, ws %zu); nothing launched\n", n_in, n_in > 0 ? in_sizes[0] : -1, out_size, ws_size); grid = -1; return; }
        int dev = 0, cus = 0, per_cu = 0;
        if (hipGetDevice(&dev) != hipSuccess || hipDeviceGetAttribute(&cus, hipDeviceAttributeMultiprocessorCount, dev) != hipSuccess) { grid = -1; return; }
        if (hipFuncSetAttribute((const void*)fwd_kernel, hipFuncAttributeMaxDynamicSharedMemorySize, LDS_BYTES) != hipSuccess) { fprintf(stderr, "kernel_launch: hipFuncSetAttribute failed\n"); grid = -1; return; }
        if (hipOccupancyMaxActiveBlocksPerMultiprocessor(&per_cu, (const void*)fwd_kernel, NWAVES * 64, LDS_BYTES) != hipSuccess || per_cu < 1) {
            fprintf(stderr, "kernel_launch: occupancy query reports %d workgroups per CU\n", per_cu); per_cu = 1; }
        (void)hipGetLastError();
        grid = cus;
        if (grid > 256) grid = 256;
        if (grid % 8 != 0) grid -= grid % 8;
    }
    if (grid <= 0) return;
    if (hipMemsetAsync((char*)d_ws + WS_CTL, 0, CTL_ZERO_BYTES, stream) != hipSuccess) return;
    Args a{};
    for (int i = 0; i < 34; ++i) a.in[i] = (const float*)d_in[i];
    a.out = (float*)d_out; a.ws = (unsigned char*)d_ws;
    if (MK_N_LAUNCHES == 1) {
        a.ph_lo = 0; a.ph_hi = NPHASE;
        hipLaunchKernelGGL(fwd_kernel, dim3(grid), dim3(NWAVES * 64), LDS_BYTES, stream, a);
    } else {
        for (int k = 0; k < NPHASE + 1; ++k) { if (!((RUN_MASK >> k) & 1)) continue; a.ph_lo = k; a.ph_hi = k + 1; hipLaunchKernelGGL(fwd_kernel, dim3(grid), dim3(NWAVES * 64), LDS_BYTES, stream, a); }
    }
}
```
